# Optimizing an MI355X kernel written in HIP

```python
import math
import jax, jax.numpy as jnp
from jax import lax
import numpy as np

D_MODEL = 1024
BATCH = 2
SEQ = 8192
DEPTH = 1

HEAD_DIM = 64
D_MIX = D_MODEL
NSA_HEADS = 8
NSA_KV_HEADS = 2
NSA_Q_PER_KV = NSA_HEADS // NSA_KV_HEADS
DIL_HEADS = 8
W_NSA = NSA_HEADS * HEAD_DIM
W_KV = NSA_KV_HEADS * HEAD_DIM
W_DIL = DIL_HEADS * HEAD_DIM
CMP_LEN = 32
CMP_STRIDE = 16
CMP_HIDDEN = 256
SEL_BLOCK = 64
SEL_TOP_N = 16
SWA_WINDOW = 512
DIL_PATTERNS = ((128, 1), (512, 4), (2048, 16))
BLOCK = 128
ROPE_THETA = 500000.0
ROPE_DIMS = HEAD_DIM // 4
RMS_EPS = 1e-6
NEG_INF = -1e30
FORCE_SCORE = 1e4
IN_SPLITS = (W_NSA,
             W_KV, W_KV,
             W_KV, W_KV,
             W_KV, W_KV,
             3 * NSA_HEADS,
             W_NSA,
             W_DIL, W_DIL, W_DIL,
             W_DIL)
D_IN = sum(IN_SPLITS)

kernel_name = "hymba_nsa_dilated_hybrid"


def rmsnorm(x, g):
    xf = x.astype(jnp.float32)
    y = xf * lax.rsqrt(jnp.mean(xf * xf, axis=-1, keepdims=True) + RMS_EPS)
    return (y * g.astype(jnp.float32)).astype(x.dtype)


def rope_tables(positions):
    inv = 1.0 / (ROPE_THETA ** (jnp.arange(0, ROPE_DIMS, 2, dtype=jnp.float32) / ROPE_DIMS))
    ang = positions.astype(jnp.float32)[..., None] * inv
    return jnp.cos(ang), jnp.sin(ang)


def apply_rope(x, cos, sin):
    shape = (cos.shape[0],) + (1,) * (x.ndim - 3) + cos.shape[1:]
    c = cos.reshape(shape)
    s = sin.reshape(shape)
    half = ROPE_DIMS // 2
    xf = x.astype(jnp.float32)
    x1 = xf[..., :half]
    x2 = xf[..., half:ROPE_DIMS]
    out = jnp.concatenate([x1 * c - x2 * s, x2 * c + x1 * s, xf[..., ROPE_DIMS:]], axis=-1)
    return out.astype(x.dtype)


def banded_attention(q, k, v, window):
    B, G, R, L, D = q.shape
    nblk = -(-L // BLOCK)
    Lp = nblk * BLOCK
    nprev = -(-window // BLOCK)
    qp = jnp.pad(q, ((0, 0), (0, 0), (0, 0), (0, Lp - L), (0, 0)))
    kp = jnp.pad(k, ((0, 0), (0, 0), (nprev * BLOCK, Lp - L), (0, 0)))
    vp = jnp.pad(v, ((0, 0), (0, 0), (nprev * BLOCK, Lp - L), (0, 0)))
    qb = qp.reshape(B, G, R, nblk, BLOCK, D)
    kb = kp.reshape(B, G, nprev + nblk, BLOCK, D)
    vb = vp.reshape(B, G, nprev + nblk, BLOCK, D)
    kw = jnp.concatenate([kb[:, :, j:j + nblk] for j in range(nprev + 1)], axis=3)
    vw = jnp.concatenate([vb[:, :, j:j + nblk] for j in range(nprev + 1)], axis=3)
    i = jnp.arange(BLOCK)[:, None]
    c = jnp.arange((nprev + 1) * BLOCK)[None, :]
    dist = nprev * BLOCK + i - c
    kabs = (jnp.arange(nblk)[:, None, None] - nprev) * BLOCK + c[None]
    mask = (dist >= 0)[None] & (dist <= window)[None] & (kabs >= 0)
    s = jnp.einsum('bgrnqd,bgnkd->bgrnqk', qb, kw).astype(jnp.float32) * (HEAD_DIM ** -0.5)
    s = jnp.where(mask, s, NEG_INF)
    m = jnp.max(s, axis=-1, keepdims=True)
    e = jnp.exp(s - m)
    den = jnp.sum(e, axis=-1, keepdims=True)
    p = (e / den).astype(v.dtype)
    out = jnp.einsum('bgrnqk,bgnkd->bgrnqd', p, vw).reshape(B, G, R, Lp, D)[:, :, :, :L]
    lse = (m[..., 0] + jnp.log(den[..., 0])).reshape(B, G, R, Lp)[..., :L]
    return out, lse


def compress_blocks(k, pos_emb, w1, w2):
    B, G, S, D = k.shape
    n_cmp = (S - CMP_LEN) // CMP_STRIDE + 1
    idx = jnp.arange(n_cmp)[:, None] * CMP_STRIDE + jnp.arange(CMP_LEN)[None, :]
    blocks = k[:, :, idx] + pos_emb
    flat = blocks.reshape(B, G, n_cmp, CMP_LEN * D)
    return jax.nn.silu(flat @ w1) @ w2


def nsa_compressed_and_selected(q, k_cmp, v_cmp, k_slc, v_slc):
    B, G, R, S, D = q.shape
    n_cmp = k_cmp.shape[2]
    n_sel = S // SEL_BLOCK
    top_n = min(SEL_TOP_N, n_sel)
    scale = HEAD_DIM ** -0.5
    cmp_end = jnp.arange(n_cmp) * CMP_STRIDE + CMP_LEN - 1
    ratio = SEL_BLOCK // CMP_STRIDE
    offs = np.array([m - n for m in range(ratio) for n in range(CMP_LEN // CMP_STRIDE)], dtype=np.int32)
    cidx = jnp.arange(n_sel)[:, None] * ratio + offs[None, :]
    cvalid = (cidx >= 0) & (cidx < n_cmp)
    cidx = jnp.clip(cidx, 0, n_cmp - 1)
    kb = k_slc.reshape(B, G, n_sel, SEL_BLOCK, D)
    vb = v_slc.reshape(B, G, n_sel, SEL_BLOCK, D)
    bi = jnp.arange(B)[:, None, None, None]
    gi = jnp.arange(G)[None, :, None, None]
    blk = jnp.arange(n_sel)

    def one_block(b):
        t = b * BLOCK + jnp.arange(BLOCK)
        qb = lax.dynamic_slice_in_dim(q, b * BLOCK, BLOCK, axis=3)
        s = jnp.einsum('bgrqd,bgcd->bgrqc', qb, k_cmp).astype(jnp.float32) * scale
        valid = cmp_end[None, :] <= t[:, None]
        s = jnp.where(valid, s, NEG_INF)
        m = jnp.max(s, axis=-1, keepdims=True)
        p = jnp.where(valid, jnp.exp(s - m), 0.0)
        p = p / jnp.maximum(jnp.sum(p, axis=-1, keepdims=True), 1e-30)
        o_cmp = jnp.einsum('bgrqc,bgcd->bgrqd', p.astype(v_cmp.dtype), v_cmp)
        imp = jnp.sum(p, axis=2)
        imp_sel = jnp.sum(jnp.where(cvalid, imp[..., cidx], 0.0), axis=-1)
        cur = t // SEL_BLOCK
        blk_valid = blk[None, :] <= cur[:, None]
        forced = (blk[None, :] == 0) | (blk[None, :] == cur[:, None]) | (blk[None, :] == cur[:, None] - 1)
        score = jnp.where(forced, FORCE_SCORE, imp_sel)
        score = jnp.where(blk_valid, score, -1.0)
        _, idx = lax.top_k(score, top_n)
        sel_ok = idx <= cur[:, None]
        ksel = kb[bi, gi, idx]
        vsel = vb[bi, gi, idx]
        s2 = jnp.einsum('bgrqd,bgqnld->bgrqnl', qb, ksel).astype(jnp.float32) * scale
        kpos = idx[..., None] * SEL_BLOCK + jnp.arange(SEL_BLOCK)
        ok = sel_ok[..., None] & (kpos <= t[:, None, None])
        s2 = jnp.where(ok[:, :, None], s2, NEG_INF)
        p2 = jax.nn.softmax(s2.reshape(B, G, R, BLOCK, top_n * SEL_BLOCK), axis=-1)
        p2 = p2.reshape(B, G, R, BLOCK, top_n, SEL_BLOCK).astype(v_slc.dtype)
        o_slc = jnp.einsum('bgrqnl,bgqnld->bgrqd', p2, vsel)
        return o_cmp, o_slc

    o_cmp, o_slc = lax.map(one_block, jnp.arange(S // BLOCK))
    o_cmp = jnp.transpose(o_cmp, (1, 2, 3, 0, 4, 5)).reshape(B, G, R, S, D)
    o_slc = jnp.transpose(o_slc, (1, 2, 3, 0, 4, 5)).reshape(B, G, R, S, D)
    return o_cmp, o_slc


def dilated_mixture(q, k, v):
    B, H, S, D = q.shape
    outs, lses = [], []
    for window, dil in DIL_PATTERNS:
        L = S // dil
        qd = q.reshape(B, H, L, dil, D).transpose(0, 1, 3, 2, 4).reshape(B, H * dil, 1, L, D)
        kd = k.reshape(B, H, L, dil, D).transpose(0, 1, 3, 2, 4).reshape(B, H * dil, L, D)
        vd = v.reshape(B, H, L, dil, D).transpose(0, 1, 3, 2, 4).reshape(B, H * dil, L, D)
        o, lse = banded_attention(qd, kd, vd, window // dil)
        outs.append(o.reshape(B, H, dil, L, D).transpose(0, 1, 3, 2, 4).reshape(B, H, S, D))
        lses.append(lse.reshape(B, H, dil, L).transpose(0, 1, 3, 2).reshape(B, H, S))
    w = jax.nn.softmax(jnp.stack(lses, axis=0), axis=0)
    o = jnp.sum(w[..., None] * jnp.stack(outs, axis=0).astype(jnp.float32), axis=0)
    return o.astype(q.dtype)


def setup_inputs(seed: int = 0) -> dict:
    key = jax.random.key(seed)
    ks = jax.random.split(key, 14)
    f32 = jnp.float32
    x = jax.random.normal(ks[0], (BATCH, SEQ, D_MODEL), f32)
    offs = jax.random.randint(ks[1], (BATCH, 1), 0, 4096, dtype=jnp.int32)
    positions = offs + jnp.arange(SEQ, dtype=jnp.int32)[None, :]
    pre_norm_g = 1.0 + 0.02 * jax.random.normal(ks[2], (DEPTH, D_MODEL), f32)
    w_in = jax.random.normal(ks[3], (DEPTH, D_MODEL, D_IN), f32) * D_MODEL ** -0.5
    cmp_k_pos = 0.1 * jax.random.normal(ks[4], (DEPTH, CMP_LEN, HEAD_DIM), f32)
    cmp_k_w1 = jax.random.normal(ks[5], (DEPTH, CMP_LEN * HEAD_DIM, CMP_HIDDEN), f32) * (CMP_LEN * HEAD_DIM) ** -0.5
    cmp_k_w2 = jax.random.normal(ks[6], (DEPTH, CMP_HIDDEN, HEAD_DIM), f32) * CMP_HIDDEN ** -0.5
    cmp_v_pos = 0.1 * jax.random.normal(ks[7], (DEPTH, CMP_LEN, HEAD_DIM), f32)
    cmp_v_w1 = jax.random.normal(ks[8], (DEPTH, CMP_LEN * HEAD_DIM, CMP_HIDDEN), f32) * (CMP_LEN * HEAD_DIM) ** -0.5
    cmp_v_w2 = jax.random.normal(ks[9], (DEPTH, CMP_HIDDEN, HEAD_DIM), f32) * CMP_HIDDEN ** -0.5
    w_out = jax.random.normal(ks[10], (DEPTH, D_MIX, D_MODEL), f32) * D_MIX ** -0.5
    post_norm_g = 1.0 + 0.02 * jax.random.normal(ks[11], (DEPTH, D_MODEL), f32)
    return {"x": x, "positions": positions, "pre_norm_g": pre_norm_g, "w_in": w_in,
            "cmp_k_pos": cmp_k_pos, "cmp_k_w1": cmp_k_w1, "cmp_k_w2": cmp_k_w2,
            "cmp_v_pos": cmp_v_pos, "cmp_v_w1": cmp_v_w1, "cmp_v_w2": cmp_v_w2,
            "w_out": w_out, "post_norm_g": post_norm_g}


def reference(x, positions, pre_norm_g, w_in, cmp_k_pos, cmp_k_w1, cmp_k_w2,
              cmp_v_pos, cmp_v_w1, cmp_v_w2, w_out, post_norm_g):
    B, S, _ = x.shape
    G, R, D = NSA_KV_HEADS, NSA_Q_PER_KV, HEAD_DIM
    cos, sin = rope_tables(positions)
    for layer in range(DEPTH):
        h = rmsnorm(x, pre_norm_g[layer])
        proj = h @ w_in[layer]
        parts, start = [], 0
        for width in IN_SPLITS:
            parts.append(proj[..., start:start + width])
            start += width
        (q_a, k_cmp, v_cmp, k_slc, v_slc, k_win, v_win, gate_a, z_a,
         q_b, k_b, v_b, z_b) = parts

        qa = apply_rope(q_a.reshape(B, S, G, R, D).transpose(0, 2, 3, 1, 4), cos, sin)
        kv = lambda t: t.reshape(B, S, G, D).transpose(0, 2, 1, 3)
        kc = compress_blocks(apply_rope(kv(k_cmp), cos, sin), cmp_k_pos[layer], cmp_k_w1[layer], cmp_k_w2[layer])
        vc = compress_blocks(kv(v_cmp), cmp_v_pos[layer], cmp_v_w1[layer], cmp_v_w2[layer])
        o_cmp, o_slc = nsa_compressed_and_selected(qa, kc, vc, apply_rope(kv(k_slc), cos, sin), kv(v_slc))
        o_win, _ = banded_attention(qa, apply_rope(kv(k_win), cos, sin), kv(v_win), SWA_WINDOW - 1)
        g = jax.nn.sigmoid(gate_a.astype(jnp.float32)).reshape(B, S, 3, G, R).transpose(2, 0, 3, 4, 1)[..., None]
        o_a = (g[0] * o_cmp + g[1] * o_slc + g[2] * o_win).astype(x.dtype)
        o_a = o_a.transpose(0, 3, 1, 2, 4).reshape(B, S, W_NSA)

        heads = lambda t: t.reshape(B, S, DIL_HEADS, D).transpose(0, 2, 1, 3)
        o_b = dilated_mixture(apply_rope(heads(q_b), cos, sin), apply_rope(heads(k_b), cos, sin), heads(v_b))
        o_b = o_b.transpose(0, 2, 1, 3).reshape(B, S, W_DIL)

        mixed = jnp.concatenate([o_a * jax.nn.silu(z_a), o_b * jax.nn.silu(z_b)], axis=-1)
        x = x + rmsnorm(mixed @ w_out[layer], post_norm_g[layer])
    return x
```

```cpp
#include <hip/hip_runtime.h>
#include <hip/hip_cooperative_groups.h>
#include <cstdio>
#include <cstdint>
namespace cg = cooperative_groups;

constexpr int NB = 2, SEQ = 8192, DM = 1024, NTOK = NB * SEQ;
constexpr int NP = 4096;
constexpr int D_IN = 3864;
constexpr int C_QA = 0, C_KCMP = 512, C_VCMP = 640, C_KSLC = 768, C_VSLC = 896, C_KWIN = 1024, C_VWIN = 1152,
              C_GATE = 1280, C_ZA = 1536, C_QB = 2048, C_KB = 2560, C_VB = 3072, C_ZB = 3584;
constexpr float C2 = 0.18033688011112042f;
constexpr float RMS_EPS = 1e-6f;
constexpr int NTHR = 512, NWAVE = 8;

constexpr size_t MiB = 1u << 20;
constexpr size_t WS_WTIN = 2 * MiB;
constexpr size_t WS_CMPB = 14 * MiB + 256 * 1024;
constexpr size_t WS_ROPE = 15 * MiB;
constexpr size_t WS_GATE = 16 * MiB;
constexpr size_t WS_KC = 18 * MiB;
constexpr size_t WS_VC = 18 * MiB + 512 * 1024;
constexpr size_t WS_LSEB = 19 * MiB;
constexpr size_t WS_H = 32 * MiB;
constexpr size_t WS_PROJ = 64 * MiB;
constexpr size_t WS_OB = 192 * MiB;
constexpr size_t WS_END = 240 * MiB;

typedef unsigned short bf16;
typedef unsigned int u32;

struct Args {
    const float* x; const int* pos; const float* pre_g; const float* w_in;
    const float* ck_pos; const float* ck_w1; const float* ck_w2;
    const float* cv_pos; const float* cv_w1; const float* cv_w2;
    const float* w_out; const float* post_g;
    float* out; unsigned char* ws;
    int ph_lo, ph_hi;
};

__device__ __forceinline__ u32 f2bf(float f) { u32 u = __builtin_bit_cast(u32, f); return (u + 0x7fffu + ((u >> 16) & 1u)) >> 16; }
__device__ __forceinline__ float bf2f(u32 b) { return __builtin_bit_cast(float, b << 16); }
__device__ __forceinline__ u32 pk2(float lo, float hi) { return f2bf(lo) | (f2bf(hi) << 16); }
__device__ __forceinline__ float bflo(u32 w) { return __builtin_bit_cast(float, w << 16); }
__device__ __forceinline__ float bfhi(u32 w) { return __builtin_bit_cast(float, w & 0xffff0000u); }
__device__ __forceinline__ float wave_sum(float v) {
#pragma unroll
    for (int o = 1; o < 64; o <<= 1) v += __shfl_xor(v, o);
    return v;
}
__device__ __forceinline__ float wave_max(float v) {
#pragma unroll
    for (int o = 1; o < 64; o <<= 1) v = fmaxf(v, __shfl_xor(v, o));
    return v;
}
__device__ __forceinline__ float silu_f(float v) { return v / (1.f + __expf(-v)); }
__device__ __forceinline__ float sigmoid_f(float v) { return 1.f / (1.f + __expf(-v)); }

__device__ __forceinline__ int wcol_of_n(int n) {
    if (n < 1304) return n;
    if (n < 1536) return -1;
    return n - 232;
}
__device__ void p0_prologue(const Args& a, float* lds) {
    const int tid = threadIdx.x, lane = tid & 63, wave = __builtin_amdgcn_readfirstlane(tid >> 6);
    const int gw = blockIdx.x * NWAVE + wave, ngw = gridDim.x * NWAVE;
    const int gt = blockIdx.x * NTHR + tid, ngt = gridDim.x * NTHR;
    bf16* H = (bf16*)(a.ws + WS_H);
    for (int row = gw; row < NTOK; row += ngw) {
        const float4* xr = (const float4*)(a.x + (size_t)row * DM) + lane;
        const float4* gr = (const float4*)a.pre_g + lane;
        float4 v[4]; float s = 0.f;
#pragma unroll
        for (int j = 0; j < 4; ++j) { v[j] = xr[64 * j]; s += v[j].x * v[j].x + v[j].y * v[j].y + v[j].z * v[j].z + v[j].w * v[j].w; }
        s = wave_sum(s);
        const float rinv = rsqrtf(s * (1.f / DM) + RMS_EPS);
        uint2* o = (uint2*)(H + (size_t)row * DM) + lane;
#pragma unroll
        for (int j = 0; j < 4; ++j) { const float4 g = gr[64 * j];
            uint2 w; w.x = pk2(v[j].x * rinv * g.x, v[j].y * rinv * g.y); w.y = pk2(v[j].z * rinv * g.z, v[j].w * rinv * g.w); o[64 * j] = w; }
    }
    bf16* WT = (bf16*)(a.ws + WS_WTIN);
    for (int it = gt; it < NP * (DM / 8); it += ngt) {
        const int n = it % NP, kc = it / NP, k0 = kc * 8;
        const int c = wcol_of_n(n);
        float f[8];
#pragma unroll
        for (int i = 0; i < 8; ++i) f[i] = (c >= 0) ? a.w_in[(size_t)(k0 + i) * D_IN + c] : 0.f;
        uint4 w; w.x = pk2(f[0], f[1]); w.y = pk2(f[2], f[3]); w.z = pk2(f[4], f[5]); w.w = pk2(f[6], f[7]);
        *(uint4*)(WT + (size_t)n * DM + k0) = w;
    }
    float* RT = (float*)(a.ws + WS_ROPE);
    for (int it = gt; it < NTOK * 8; it += ngt) {
        const int tok = it >> 3, i = it & 7;
        const float inv[8] = {1.0f, 0.193922758102417f, 0.03760603070259094f, 0.00729266507551074f, 0.001414213445968926f,
                              0.00027424818836152554f, 5.318296462064609e-05f, 1.0313385246263351e-05f};
        float iv = inv[0];
#pragma unroll
        for (int q = 1; q < 8; ++q) iv = (i == q) ? inv[q] : iv;
        const float ang = (float)a.pos[tok] * iv;
        RT[tok * 16 + i] = cosf(ang); RT[tok * 16 + 8 + i] = sinf(ang);
    }
    if (blockIdx.x < 16) {
        const int m = blockIdx.x >> 3, n0 = (blockIdx.x & 7) * 32, nn = tid & 31, ks = tid >> 5;
        const float* pe = m ? a.cv_pos : a.ck_pos; const float* w1 = m ? a.cv_w1 : a.ck_w1;
        float acc = 0.f;
        for (int k = ks * 128; k < ks * 128 + 128; ++k) acc += pe[k] * w1[(size_t)k * 256 + n0 + nn];
        lds[ks * 32 + nn] = acc;
        __syncthreads();
        if (tid < 32) { float s = 0.f; for (int q = 0; q < 16; ++q) s += lds[q * 32 + tid]; ((float*)(a.ws + WS_CMPB))[m * 256 + n0 + tid] = s; }
        __syncthreads();
    }
}

__device__ __forceinline__ void epi16(const Args& a, int row, int n16, float (&v)[16]) {
    if (n16 >= C_GATE && n16 < C_ZA) {
        if (n16 >= 1304) return;
        float* G = (float*)(a.ws + WS_GATE) + (size_t)row * 24;
#pragma unroll
        for (int i = 0; i < 16; ++i) { const int gi = n16 - C_GATE + i; if (gi < 24) G[gi] = sigmoid_f(v[i]); }
        return;
    }
    const bool isq = (n16 < C_KCMP) || (n16 >= C_QB && n16 < C_KB);
    const bool isz = (n16 >= C_ZA && n16 < C_QB) || (n16 >= C_ZB);
    const bool isk = (n16 >= C_KCMP && n16 < C_VCMP) || (n16 >= C_KSLC && n16 < C_VSLC) || (n16 >= C_KWIN && n16 < C_VWIN) || (n16 >= C_KB && n16 < C_VB);
    if ((isq || isk) && (n16 & 63) == 0) {
        const float* rt = (const float*)(a.ws + WS_ROPE) + (size_t)row * 16;
#pragma unroll
        for (int i = 0; i < 8; ++i) { const float c = rt[i], s = rt[8 + i], x1 = v[i], x2 = v[8 + i]; v[i] = x1 * c - x2 * s; v[8 + i] = x2 * c + x1 * s; }
    }
    if (isq) {
#pragma unroll
        for (int i = 0; i < 16; ++i) v[i] *= C2;
    }
    if (isz) {
#pragma unroll
        for (int i = 0; i < 16; ++i) v[i] = silu_f(v[i]);
    }
    bf16* P = (bf16*)(a.ws + WS_PROJ) + (size_t)row * NP + n16;
    uint4 w0, w1;
    w0.x = pk2(v[0], v[1]); w0.y = pk2(v[2], v[3]); w0.z = pk2(v[4], v[5]); w0.w = pk2(v[6], v[7]);
    w1.x = pk2(v[8], v[9]); w1.y = pk2(v[10], v[11]); w1.z = pk2(v[12], v[13]); w1.w = pk2(v[14], v[15]);
    ((uint4*)P)[0] = w0; ((uint4*)P)[1] = w1;
}
__device__ void p1_naive(const Args& a, float* lds) {
    const int tid = threadIdx.x, tx = tid & 15, ty = tid >> 4;
    float* As = lds;
    float* Bs = lds + 32 * 64;
    const bf16* H = (const bf16*)(a.ws + WS_H); const bf16* WT = (const bf16*)(a.ws + WS_WTIN);
    for (int tile = blockIdx.x; tile < (NTOK / 64) * (NP / 256); tile += gridDim.x) {
        const int pm = tile / (NP / 256), pn = tile % (NP / 256);
        const int row0 = pm * 64, n0 = pn * 256;
        float acc[2][16];
#pragma unroll
        for (int r = 0; r < 2; ++r)
#pragma unroll
            for (int c = 0; c < 16; ++c) acc[r][c] = 0.f;
        for (int k0 = 0; k0 < DM; k0 += 32) {
            { const int r = tid >> 3, kq = (tid & 7) * 4;
              const uint2 w = *(const uint2*)(H + (size_t)(row0 + r) * DM + k0 + kq);
              As[(kq + 0) * 64 + r] = bflo(w.x); As[(kq + 1) * 64 + r] = bfhi(w.x); As[(kq + 2) * 64 + r] = bflo(w.y); As[(kq + 3) * 64 + r] = bfhi(w.y); }
            { const int n = tid >> 1, kh = (tid & 1) * 16;
              const uint4 w0 = *(const uint4*)(WT + (size_t)(n0 + n) * DM + k0 + kh);
              const uint4 w1 = *(const uint4*)(WT + (size_t)(n0 + n) * DM + k0 + kh + 8);
              float* b = Bs + kh * 256 + n;
              b[0 * 256] = bflo(w0.x); b[1 * 256] = bfhi(w0.x); b[2 * 256] = bflo(w0.y); b[3 * 256] = bfhi(w0.y);
              b[4 * 256] = bflo(w0.z); b[5 * 256] = bfhi(w0.z); b[6 * 256] = bflo(w0.w); b[7 * 256] = bfhi(w0.w);
              b[8 * 256] = bflo(w1.x); b[9 * 256] = bfhi(w1.x); b[10 * 256] = bflo(w1.y); b[11 * 256] = bfhi(w1.y);
              b[12 * 256] = bflo(w1.z); b[13 * 256] = bfhi(w1.z); b[14 * 256] = bflo(w1.w); b[15 * 256] = bfhi(w1.w); }
            __syncthreads();
#pragma unroll 4
            for (int k = 0; k < 32; ++k) {
                const float a0 = As[k * 64 + 2 * ty], a1 = As[k * 64 + 2 * ty + 1];
                const float4* bp = (const float4*)(Bs + k * 256 + 16 * tx);
                const float4 b0 = bp[0], b1 = bp[1], b2 = bp[2], b3 = bp[3];
                const float bb[16] = {b0.x, b0.y, b0.z, b0.w, b1.x, b1.y, b1.z, b1.w, b2.x, b2.y, b2.z, b2.w, b3.x, b3.y, b3.z, b3.w};
#pragma unroll
                for (int c = 0; c < 16; ++c) { acc[0][c] += a0 * bb[c]; acc[1][c] += a1 * bb[c]; }
            }
            __syncthreads();
        }
        epi16(a, row0 + 2 * ty, n0 + 16 * tx, acc[0]);
        epi16(a, row0 + 2 * ty + 1, n0 + 16 * tx, acc[1]);
    }
}

template <int R> struct WAttn {
    float m[R], l[R], o[R];
    __device__ __forceinline__ void init() {
#pragma unroll
        for (int r = 0; r < R; ++r) { m[r] = -INFINITY; l[r] = 0.f; o[r] = 0.f; }
    }
    __device__ __forceinline__ void scores(const float* qs, const bf16* krow, float (&s)[R]) {
#pragma unroll
        for (int r = 0; r < R; ++r) s[r] = 0.f;
        uint4 kc = ((const uint4*)krow)[0];
#pragma unroll 1
        for (int i = 0; i < 8; ++i) {
            const uint4 kn = ((const uint4*)krow)[i < 7 ? i + 1 : 7];
            const float k0 = bflo(kc.x), k1 = bfhi(kc.x), k2 = bflo(kc.y), k3 = bfhi(kc.y), k4 = bflo(kc.z), k5 = bfhi(kc.z), k6 = bflo(kc.w), k7 = bfhi(kc.w);
#pragma unroll
            for (int r = 0; r < R; ++r) {
                const float4 q0 = *(const float4*)(qs + r * 64 + i * 8), q1 = *(const float4*)(qs + r * 64 + i * 8 + 4);
                s[r] += q0.x * k0 + q0.y * k1 + q0.z * k2 + q0.w * k3 + q1.x * k4 + q1.y * k5 + q1.z * k6 + q1.w * k7;
            }
            kc = kn;
        }
    }
    __device__ __forceinline__ void chunk(const float* qs, const bf16* krow, const bf16* vrow, bool valid, int lane) {
        float s[R]; scores(qs, krow, s);
        float p[R];
#pragma unroll
        for (int r = 0; r < R; ++r) {
            const float sv = valid ? s[r] : -INFINITY;
            const float mx = wave_max(sv);
            const float mn = fmaxf(m[r], mx);
            float alpha = 1.f, pv = 0.f;
            if (mn > -INFINITY) { alpha = exp2f(m[r] - mn); pv = valid ? exp2f(sv - mn) : 0.f; }
            l[r] = l[r] * alpha + wave_sum(pv); o[r] *= alpha; m[r] = mn; p[r] = pv;
        }
        const unsigned long long vaddr = (unsigned long long)vrow;
#pragma unroll 4
        for (int key = 0; key < 64; ++key) {
            const unsigned long long va = __shfl(vaddr, key);
            const float vv = bf2f(((const bf16*)va)[lane]);
#pragma unroll
            for (int r = 0; r < R; ++r) o[r] += __shfl(p[r], key) * vv;
        }
    }
};

__device__ void p2_compress(const Args& a, float* lds_wave, int item, int lane) {
    const int prob = item >> 6, cg8 = item & 63, kv = prob & 1, bg = prob >> 1, b = bg >> 1, g = bg & 1;
    const int c0 = cg8 * 8;
    const float* w1 = kv ? a.cv_w1 : a.ck_w1; const float* w2 = kv ? a.cv_w2 : a.ck_w2;
    const float* bias = (const float*)(a.ws + WS_CMPB) + kv * 256;
    const bf16* src = (const bf16*)(a.ws + WS_PROJ) + (size_t)b * SEQ * NP + (kv ? C_VCMP : C_KCMP) + g * 64;
    float acc[8][4];
#pragma unroll
    for (int c = 0; c < 8; ++c)
#pragma unroll
        for (int i = 0; i < 4; ++i) acc[c][i] = 0.f;
    for (int k = 0; k < 2048; ++k) {
        const int tok_off = k >> 6, d = k & 63;
        float w[4];
#pragma unroll
        for (int i = 0; i < 4; ++i) w[i] = w1[(size_t)k * 256 + lane + 64 * i];
#pragma unroll
        for (int c = 0; c < 8; ++c) {
            int tok = 16 * (c0 + c) + tok_off; tok = tok < SEQ ? tok : SEQ - 1;
            const float av = bf2f(src[(size_t)tok * NP + d]);
#pragma unroll
            for (int i = 0; i < 4; ++i) acc[c][i] += av * w[i];
        }
    }
#pragma unroll
    for (int c = 0; c < 8; ++c)
#pragma unroll
        for (int i = 0; i < 4; ++i) lds_wave[c * 256 + lane + 64 * i] = silu_f(acc[c][i] + bias[lane + 64 * i]);
    __builtin_amdgcn_s_waitcnt(0xc07f);
    asm volatile("" ::: "memory");
    float out[8];
#pragma unroll
    for (int c = 0; c < 8; ++c) out[c] = 0.f;
    for (int n = 0; n < 256; ++n) {
        const float w = w2[n * 64 + lane];
#pragma unroll
        for (int c = 0; c < 8; ++c) out[c] += lds_wave[c * 256 + n] * w;
    }
    bf16* dst = (bf16*)(a.ws + (kv ? WS_VC : WS_KC)) + (size_t)bg * 512 * 64;
#pragma unroll
    for (int c = 0; c < 8; ++c) dst[(size_t)(c0 + c) * 64 + lane] = (bf16)((c0 + c) < 511 ? f2bf(out[c]) : 0u);
    asm volatile("" ::: "memory");
}
__device__ void p2_dilated(const Args& a, float* qs, int item, int lane) {
    const int h = item & 7, tok = (item >> 3) & (NTOK - 1), p = item >> 17;
    const int b = tok >> 13, t = tok & (SEQ - 1);
    const int dil = (p == 0) ? 1 : (p == 1) ? 4 : 16, sh = (p == 0) ? 0 : (p == 1) ? 2 : 4;
    const bf16* P = (const bf16*)(a.ws + WS_PROJ);
    qs[lane] = bf2f(P[(size_t)tok * NP + C_QB + h * 64 + lane]);
    __builtin_amdgcn_s_waitcnt(0xc07f); asm volatile("" ::: "memory");
    const int i = t >> sh, r = t & (dil - 1);
    WAttn<1> A; A.init();
    for (int c = 0; c < 3; ++c) {
        const int jd = i - 191 + 64 * c + lane;
        const bool valid = (jd >= 0) && (jd >= i - 128) && (jd <= i);
        const int jc = jd < 0 ? 0 : jd;
        const size_t krow = (size_t)(b * SEQ + jc * dil + r) * NP;
        A.chunk(qs, P + krow + C_KB + h * 64, P + krow + C_VB + h * 64, valid, lane);
    }
    bf16* OB = (bf16*)(a.ws + WS_OB) + (size_t)p * NTOK * 512;
    OB[(size_t)tok * 512 + h * 64 + lane] = (bf16)f2bf(A.o[0] / A.l[0]);
    if (lane == 0) ((float*)(a.ws + WS_LSEB))[((size_t)p * NTOK + tok) * 8 + h] = A.m[0] + log2f(A.l[0]);
    asm volatile("" ::: "memory");
}

__device__ void p3_combine(const Args& a, int tok, int lane) {
    const int h = lane >> 3;
    const float* L = (const float*)(a.ws + WS_LSEB);
    const float l0 = L[((size_t)0 * NTOK + tok) * 8 + h], l1 = L[((size_t)1 * NTOK + tok) * 8 + h], l2 = L[((size_t)2 * NTOK + tok) * 8 + h];
    const float mx = fmaxf(l0, fmaxf(l1, l2));
    float w0 = exp2f(l0 - mx), w1 = exp2f(l1 - mx), w2 = exp2f(l2 - mx);
    const float inv = 1.f / (w0 + w1 + w2); w0 *= inv; w1 *= inv; w2 *= inv;
    const bf16* OB = (const bf16*)(a.ws + WS_OB);
    const uint4 o0 = *(const uint4*)(OB + ((size_t)0 * NTOK + tok) * 512 + lane * 8);
    const uint4 o1 = *(const uint4*)(OB + ((size_t)1 * NTOK + tok) * 512 + lane * 8);
    const uint4 o2 = *(const uint4*)(OB + ((size_t)2 * NTOK + tok) * 512 + lane * 8);
    const uint4 z = *(const uint4*)((const bf16*)(a.ws + WS_PROJ) + (size_t)tok * NP + C_ZB + lane * 8);
    uint4 r;
#define CMB(f) r.f = pk2((w0 * bflo(o0.f) + w1 * bflo(o1.f) + w2 * bflo(o2.f)) * bflo(z.f), (w0 * bfhi(o0.f) + w1 * bfhi(o1.f) + w2 * bfhi(o2.f)) * bfhi(z.f))
    CMB(x); CMB(y); CMB(z); CMB(w);
#undef CMB
    *(uint4*)((bf16*)(a.ws + WS_H) + (size_t)tok * DM + 512 + lane * 8) = r;
}
__device__ void p3_mixer_a(const Args& a, float* qs, float* imp, int item, int lane) {
    const int g = item & 1, tok = item >> 1, b = tok >> 13, t = tok & (SEQ - 1);
    const bf16* P = (const bf16*)(a.ws + WS_PROJ);
    const bf16* Pb = P + (size_t)b * SEQ * NP;
#pragma unroll
    for (int r = 0; r < 4; ++r) qs[r * 64 + lane] = bf2f(P[(size_t)tok * NP + C_QA + (g * 4 + r) * 64 + lane]);
#pragma unroll
    for (int i = 0; i < 8; ++i) imp[lane + 64 * i] = 0.f;
    __builtin_amdgcn_s_waitcnt(0xc07f); asm volatile("" ::: "memory");
    const float* G = (const float*)(a.ws + WS_GATE) + (size_t)tok * 24;
    float tot[4] = {0.f, 0.f, 0.f, 0.f};
    const int cur = t >> 6;
    const bf16* KC = (const bf16*)(a.ws + WS_KC) + (size_t)(b * 2 + g) * 512 * 64;
    const bf16* VC = (const bf16*)(a.ws + WS_VC) + (size_t)(b * 2 + g) * 512 * 64;
    const int cmax = (t >= 31) ? ((t - 31) >> 4) : -1;
    const int swa_base = (t & ~63) - 512;
    unsigned long long m0 = 0ull, m1 = 0ull;
    WAttn<4> A;
#pragma unroll 1
    for (int br = 0; br < 3; ++br) {
        A.init();
        const int nch = (br == 0) ? ((cmax >= 0) ? (cmax >> 6) + 1 : 0) : (br == 1) ? cur + 1 : 9;
#pragma unroll 1
        for (int c = 0; c < nch; ++c) {
            const bf16 *kp, *vp; bool valid;
            if (br == 0) { const int cc = c * 64 + lane; kp = KC + (size_t)cc * 64; vp = VC + (size_t)cc * 64; valid = cc <= cmax; }
            else if (br == 1) {
                const bool sel = (c < 64) ? ((m0 >> c) & 1ull) : ((m1 >> (c - 64)) & 1ull);
                if (!sel) continue;
                const int key = c * 64 + lane; const size_t ro = (size_t)key * NP + g * 64;
                kp = Pb + ro + C_KSLC; vp = Pb + ro + C_VSLC; valid = key <= t;
            } else {
                if (swa_base + 64 * c + 63 < 0) continue;
                const int key = swa_base + 64 * c + lane;
                valid = key >= 0 && key <= t && (t - key) <= 511;
                const int kc2 = key < 0 ? 0 : key; const size_t ro = (size_t)kc2 * NP + g * 64;
                kp = Pb + ro + C_KWIN; vp = Pb + ro + C_VWIN;
            }
            A.chunk(qs, kp, vp, valid, lane);
        }
        float rl[4];
#pragma unroll
        for (int r = 0; r < 4; ++r) { rl[r] = (A.l[r] > 0.f) ? 1.f / A.l[r] : 0.f; tot[r] += G[br * 8 + g * 4 + r] * A.o[r] * rl[r]; }
        if (br == 0) {
#pragma unroll 1
            for (int c = 0; c < nch; ++c) {
                const int cc = c * 64 + lane; float s[4]; A.scores(qs, KC + (size_t)cc * 64, s);
                float ip = 0.f;
#pragma unroll
                for (int r = 0; r < 4; ++r) ip += (cc <= cmax) ? exp2f(s[r] - A.m[r]) * rl[r] : 0.f;
                imp[cc] = ip;
            }
            __builtin_amdgcn_s_waitcnt(0xc07f); asm volatile("" ::: "memory");
            float sc[2];
#pragma unroll
            for (int q = 0; q < 2; ++q) {
                const int j = lane + 64 * q;
                float v = (j > 0 ? imp[4 * j - 1] : 0.f) + 2.f * imp[4 * j] + 2.f * imp[4 * j + 1] + 2.f * imp[4 * j + 2] + imp[4 * j + 3];
                if (j == 0 || j == cur || j == cur - 1) v = 1e4f;
                if (j > cur) v = -1.f;
                sc[q] = v;
            }
#pragma unroll 1
            for (int it = 0; it < 16; ++it) {
                float bv; int bi;
                if (sc[0] >= sc[1]) { bv = sc[0]; bi = lane; } else { bv = sc[1]; bi = lane + 64; }
#pragma unroll
                for (int off = 32; off >= 1; off >>= 1) {
                    const float ov = __shfl_xor(bv, off); const int oi = __shfl_xor(bi, off);
                    if (ov > bv || (ov == bv && oi < bi)) { bv = ov; bi = oi; }
                }
                bi = __builtin_amdgcn_readfirstlane(bi);
                if (bi <= cur) { if (bi < 64) m0 |= 1ull << bi; else m1 |= 1ull << (bi - 64); }
                if (bi == lane) sc[0] = -2.f;
                if (bi == lane + 64) sc[1] = -2.f;
            }
        }
    }
    bf16* MX = (bf16*)(a.ws + WS_H) + (size_t)tok * DM;
#pragma unroll
    for (int r = 0; r < 4; ++r) { const int col = (g * 4 + r) * 64 + lane; MX[col] = (bf16)f2bf(tot[r] * bf2f(P[(size_t)tok * NP + C_ZA + col])); }
    asm volatile("" ::: "memory");
}

__device__ void p4_naive(const Args& a, float* lds) {
    const int tid = threadIdx.x, lane = tid & 63, wave = __builtin_amdgcn_readfirstlane(tid >> 6);
    float* Ms = lds;
    float* red = lds + 16 * 1024;
    const bf16* MX = (const bf16*)(a.ws + WS_H);
    for (int blk = blockIdx.x; blk < NTOK / 16; blk += gridDim.x) {
        const int row0 = blk * 16;
        for (int i = tid; i < 16 * 1024 / 2; i += NTHR) { const u32 w = ((const u32*)(MX + (size_t)row0 * DM))[i]; Ms[2 * i] = bflo(w); Ms[2 * i + 1] = bfhi(w); }
        __syncthreads();
        float acc[16][2];
#pragma unroll
        for (int r = 0; r < 16; ++r) { acc[r][0] = 0.f; acc[r][1] = 0.f; }
        for (int k = 0; k < DM; ++k) {
            const float2 w = *(const float2*)(a.w_out + (size_t)k * DM + 2 * tid);
#pragma unroll
            for (int r = 0; r < 16; ++r) { const float m = Ms[r * 1024 + k]; acc[r][0] += m * w.x; acc[r][1] += m * w.y; }
        }
#pragma unroll
        for (int r = 0; r < 16; ++r) { const float s = wave_sum(acc[r][0] * acc[r][0] + acc[r][1] * acc[r][1]); if (lane == 0) red[r * 8 + wave] = s; }
        __syncthreads();
        const float2 pg = *(const float2*)(a.post_g + 2 * tid);
#pragma unroll
        for (int r = 0; r < 16; ++r) {
            float s = 0.f;
#pragma unroll
            for (int q = 0; q < 8; ++q) s += red[r * 8 + q];
            const float rinv = rsqrtf(s * (1.f / DM) + RMS_EPS);
            const float2 xv = *(const float2*)(a.x + (size_t)(row0 + r) * DM + 2 * tid);
            float2 o; o.x = xv.x + acc[r][0] * rinv * pg.x; o.y = xv.y + acc[r][1] * rinv * pg.y;
            *(float2*)(a.out + (size_t)(row0 + r) * DM + 2 * tid) = o;
        }
        __syncthreads();
    }
}

__global__ void __launch_bounds__(NTHR) mk_fwd(Args a) {
    __shared__ __attribute__((aligned(16))) float lds[16 * 1024 + 128];
    cg::grid_group grid = cg::this_grid();
    const int tid = threadIdx.x, lane = tid & 63, wave = __builtin_amdgcn_readfirstlane(tid >> 6);
    const int gw = blockIdx.x * NWAVE + wave, ngw = gridDim.x * NWAVE;
#define IN(k) (a.ph_lo <= (k) && (k) < a.ph_hi)
#define SEAM(k) do { if (IN(k) && IN((k) + 1)) { __threadfence(); grid.sync(); } } while (0)
    if (IN(0)) p0_prologue(a, lds);
    SEAM(0);
    if (IN(1)) p1_naive(a, lds);
    SEAM(1);
    if (IN(2)) {
        float* lw = lds + wave * 2048;
        for (int item = gw; item < 512; item += ngw) p2_compress(a, lw, item, lane);
        for (int item = gw; item < 3 * NTOK * 8; item += ngw) p2_dilated(a, lw, item, lane);
    }
    SEAM(2);
    if (IN(3)) {
        float* lw = lds + wave * 1024;
        for (int tok = gw; tok < NTOK; tok += ngw) p3_combine(a, tok, lane);
        for (int item = gw; item < NTOK * 2; item += ngw) p3_mixer_a(a, lw, lw + 256, item, lane);
    }
    SEAM(3);
    if (IN(4)) p4_naive(a, lds);
#undef IN
#undef SEAM
}

extern "C" void kernel_launch(void* const* d_in, const int* in_sizes, int n_in, void* d_out, int out_size, void* d_ws, size_t ws_size, hipStream_t stream) {
    static int grid_blocks = 0;
    if (!grid_blocks) {
        int dev = 0, cus = 0, per_cu = 0;
        hipGetDevice(&dev);
        hipDeviceGetAttribute(&cus, hipDeviceAttributeMultiprocessorCount, dev);
        hipOccupancyMaxActiveBlocksPerMultiprocessor(&per_cu, mk_fwd, NTHR, 0);
        if (per_cu < 1) per_cu = 1;
        if (per_cu > 2) per_cu = 2;
        grid_blocks = cus * per_cu;
        if (ws_size < WS_END) fprintf(stderr, "kernel_launch: workspace too small (%zu)\n", ws_size);
    }
    Args a{};
    a.x = (const float*)d_in[0]; a.pos = (const int*)d_in[1]; a.pre_g = (const float*)d_in[2]; a.w_in = (const float*)d_in[3];
    a.ck_pos = (const float*)d_in[4]; a.ck_w1 = (const float*)d_in[5]; a.ck_w2 = (const float*)d_in[6];
    a.cv_pos = (const float*)d_in[7]; a.cv_w1 = (const float*)d_in[8]; a.cv_w2 = (const float*)d_in[9];
    a.w_out = (const float*)d_in[10]; a.post_g = (const float*)d_in[11];
    a.out = (float*)d_out; a.ws = (unsigned char*)d_ws; a.ph_lo = 0; a.ph_hi = 5;
    void* args[] = {&a};
    hipError_t e = hipLaunchCooperativeKernel((void*)mk_fwd, dim3(grid_blocks), dim3(NTHR), args, 0, stream);
    if (e != hipSuccess) fprintf(stderr, "cooperative launch failed: %s (grid %d)\n", hipGetErrorString(e), grid_blocks);
}
```

```cpp
#include <hip/hip_runtime.h>
#include <hip/hip_cooperative_groups.h>
#include <cstdio>
#include <cstdint>
namespace cg = cooperative_groups;

constexpr int NB = 2, SEQ = 8192, DM = 1024, NTOK = NB * SEQ;
constexpr int NP = 4096;
constexpr int D_IN = 3864;
constexpr int C_QA = 0, C_KCMP = 512, C_VCMP = 640, C_KSLC = 768, C_VSLC = 896, C_KWIN = 1024, C_VWIN = 1152,
              C_GATE = 1280, C_ZA = 1536, C_QB = 2048, C_KB = 2560, C_VB = 3072, C_ZB = 3584;
constexpr float C2 = 0.18033688011112042f;
constexpr float RMS_EPS = 1e-6f;
constexpr int NTHR = 512, NWAVE = 8;

constexpr size_t MiB = 1u << 20;
constexpr size_t WS_WTIN = 2 * MiB;
constexpr size_t WS_CMPB = 14 * MiB + 256 * 1024;
constexpr size_t WS_ROPE = 15 * MiB;
constexpr size_t WS_GATE = 16 * MiB;
constexpr size_t WS_KC = 18 * MiB;
constexpr size_t WS_VC = 18 * MiB + 512 * 1024;
constexpr size_t WS_LSEB = 19 * MiB;
constexpr size_t WS_H = 32 * MiB;
constexpr size_t WS_PROJ = 64 * MiB;
constexpr size_t WS_OB = 192 * MiB;
constexpr size_t WS_END = 240 * MiB;

typedef unsigned short bf16;
typedef unsigned int u32;

struct Args {
    const float* x; const int* pos; const float* pre_g; const float* w_in;
    const float* ck_pos; const float* ck_w1; const float* ck_w2;
    const float* cv_pos; const float* cv_w1; const float* cv_w2;
    const float* w_out; const float* post_g;
    float* out; unsigned char* ws;
    int ph_lo, ph_hi;
};

__device__ __forceinline__ u32 f2bf(float f) { u32 u = __builtin_bit_cast(u32, f); return (u + 0x7fffu + ((u >> 16) & 1u)) >> 16; }
__device__ __forceinline__ float bf2f(u32 b) { return __builtin_bit_cast(float, b << 16); }
__device__ __forceinline__ u32 pk2(float lo, float hi) { return f2bf(lo) | (f2bf(hi) << 16); }
__device__ __forceinline__ float bflo(u32 w) { return __builtin_bit_cast(float, w << 16); }
__device__ __forceinline__ float bfhi(u32 w) { return __builtin_bit_cast(float, w & 0xffff0000u); }
__device__ __forceinline__ float wave_sum(float v) {
#pragma unroll
    for (int o = 1; o < 64; o <<= 1) v += __shfl_xor(v, o);
    return v;
}
__device__ __forceinline__ float wave_max(float v) {
#pragma unroll
    for (int o = 1; o < 64; o <<= 1) v = fmaxf(v, __shfl_xor(v, o));
    return v;
}
__device__ __forceinline__ float silu_f(float v) { return v / (1.f + __expf(-v)); }
__device__ __forceinline__ float sigmoid_f(float v) { return 1.f / (1.f + __expf(-v)); }

namespace pg8 {
#define PG8_LAS __attribute__((address_space(3)))
typedef unsigned short bf16_t;
typedef short bf16x8 __attribute__((ext_vector_type(8)));
typedef float f32x4 __attribute__((ext_vector_type(4)));
typedef unsigned u32x4 __attribute__((ext_vector_type(4)));
constexpr int BM = 256, BK = 64, HALF = 128, HTB = HALF * BK * 2  , STAGE_BYTES = 8 * HTB, NXCD = 8, WGM = 8;

__host__ __device__ __forceinline__ int lds_byte(int r, int c) { const int st = (r >> 4) * 2 + (c >> 5), rr = r & 15, cc = c & 31, ob = rr * 64 + cc * 2; return st * 1024 + (ob ^ (((ob >> 9) & 1) << 5)); }
__host__ __device__ __forceinline__ void stage_rc(int b, int& R, int& C) { const int st = b / 1024, sb = b % 1024, swz = sb ^ (((sb >> 9) & 1) << 5); R = (st >> 1) * 16 + swz / 64; C = (st & 1) * 32 + (swz % 64) / 2; }
__host__ __device__ __forceinline__ int perm32(int rho) { const int n = rho >> 4, i = rho & 15; return 8 * (i >> 2) + 4 * n + (i & 3); }

struct Unit { int pm, pn; };
struct Gemm { const bf16_t* A; const bf16_t* Bt; int M, N, K; };

struct StaticOrder {
    int nM, nN, nwg, G, c;
    __host__ __device__ void init(int M, int N, int G_, int c_) { nM = M / BM; nN = N / BM; nwg = nM * nN; G = G_; c = c_; }
    __host__ __device__ bool next(int i, Unit& u) const {
        const long L = (long)i * G + c; if (L >= nwg) return false;
        int wgid = (int)L; { const int q = nwg / NXCD, r = nwg % NXCD, xcd = wgid % NXCD, off = wgid / NXCD; wgid = (xcd < r ? xcd * (q + 1) : r * (q + 1) + (xcd - r) * q) + off; }
        const int nig = WGM * nN, gid = wgid / nig, fm = gid * WGM, gsz = (nM - fm) < WGM ? (nM - fm) : WGM;
        u.pm = fm + ((wgid % nig) % gsz); u.pn = (wgid % nig) / gsz; return true;
    }
    __device__ __forceinline__ void a_ready(const Unit&) const {}
    __device__ __forceinline__ void done(const Unit&) const {}
};

__device__ __forceinline__ unsigned cvt_pk_bf16(float lo, float hi) { unsigned r; asm volatile("v_cvt_pk_bf16_f32 %0, %1, %2" : "=v"(r) : "v"(lo), "v"(hi)); return r; }

struct EpiProj {
    static constexpr bool PERM = true, AFTER_DRAIN = false;
    bf16_t* P; float* G; const float* RT; float qscale;
    __device__ __forceinline__ void operator()(const f32x4 (&acc)[2][2][4][2], const Unit& u, int wr, int wc, int fr, int fq) const {
        const int pn = u.pn;
        const int row0 = u.pm * BM + wr * 64 + fr;
        const int col0 = pn * BM + wc * 32 + 8 * fq;
        if (pn == 5) {
            if (wc == 0 && fq < 3) {
#pragma unroll
                for (int ai = 0; ai < 2; ++ai)
#pragma unroll
                    for (int m = 0; m < 4; ++m) {
                        float* gp = G + (size_t)(row0 + ai * HALF + m * 16) * 24 + 8 * fq;
                        f32x4 v0 = acc[ai][0][m][0], v1 = acc[ai][0][m][1];
#pragma unroll
                        for (int i = 0; i < 4; ++i) { v0[i] = 1.f / (1.f + __expf(-v0[i])); v1[i] = 1.f / (1.f + __expf(-v1[i])); }
                        *(f32x4*)gp = v0; *(f32x4*)(gp + 4) = v1;
                    }
            }
            return;
        }
        const bool rope0 = (pn <= 4) || (pn >= 8 && pn <= 11);
        const bool rope1 = (pn <= 1) || (pn >= 8 && pn <= 11);
        const bool isq = (pn <= 1) || pn == 8 || pn == 9;
        const bool isz = pn == 6 || pn == 7 || pn >= 14;
        const bool ropeW = ((wc & 1) == 0) && (rope0 || rope1);
        const float sc = isq ? qscale : 1.f;
#pragma unroll
        for (int ai = 0; ai < 2; ++ai)
#pragma unroll
            for (int m = 0; m < 4; ++m) {
                const int row = row0 + ai * HALF + m * 16;
                f32x4 c0 = {1.f, 1.f, 1.f, 1.f}, c1 = c0, s0 = {0.f, 0.f, 0.f, 0.f}, s1 = s0;
                if (ropeW) { const f32x4* rt = (const f32x4*)(RT + (size_t)row * 16); c0 = rt[0]; c1 = rt[1]; s0 = rt[2]; s1 = rt[3]; }
                bf16_t* rowp = P + (size_t)row * 4096 + col0;
#pragma unroll
                for (int bj = 0; bj < 2; ++bj) {
                    f32x4 v0 = acc[ai][bj][m][0], v1 = acc[ai][bj][m][1];
                    if (ropeW && (bj ? rope1 : rope0)) {
                        f32x4 o0, o1;
#pragma unroll
                        for (int i = 0; i < 4; ++i) { o0[i] = __shfl_xor(v0[i], 16); o1[i] = __shfl_xor(v1[i], 16); }
                        if (fq == 0) { v0 = v0 * c0 - o0 * s0; v1 = v1 * c1 - o1 * s1; }
                        else if (fq == 1) { v0 = v0 * c0 + o0 * s0; v1 = v1 * c1 + o1 * s1; }
                    }
                    if (isz) {
#pragma unroll
                        for (int i = 0; i < 4; ++i) { v0[i] = v0[i] / (1.f + __expf(-v0[i])); v1[i] = v1[i] / (1.f + __expf(-v1[i])); }
                    }
                    v0 = v0 * sc; v1 = v1 * sc;
                    u32x4 w; w.x = cvt_pk_bf16(v0[0], v0[1]); w.y = cvt_pk_bf16(v0[2], v0[3]); w.z = cvt_pk_bf16(v1[0], v1[1]); w.w = cvt_pk_bf16(v1[2], v1[3]);
                    *(u32x4*)(rowp + bj * HALF) = w;
                }
            }
    }
};
template <class Epi, class Sched, bool ALIGN_EPI = false, bool SP2 = false>
__device__ __forceinline__ void gemm_phase(PG8_LAS unsigned char* lds, const Gemm g, const Sched& S, const Epi& E) {
    const int tid = threadIdx.x, wid = __builtin_amdgcn_readfirstlane(tid >> 6), lane = tid & 63, wr = wid >> 2, wc = wid & 3, fr = lane & 15, fq = lane >> 4;
    const int K = g.K, nt = K / BK;
    unsigned voffA[2], voffB[2];
#pragma unroll
    for (int i = 0; i < 2; ++i) { int R, C; stage_rc(tid * 16 + i * 8192, R, C); const int Rb = Epi::PERM ? ((R & ~31) + perm32(R & 31)) : R;
        voffA[i] = (unsigned)(R * K + C) * 2u; voffB[i] = (unsigned)(Rb * K + C) * 2u; }
    const size_t kstep = (size_t)(BK * 2);
    const size_t hstep = (size_t)HALF * K * 2;
    const size_t tstep = 2 * hstep;
    const unsigned ldsw = (unsigned)wid * 1024u;
    const int aoff = lds_byte(wr * 64 + fr, fq * 8), boff = lds_byte(wc * 32 + fr, fq * 8);
#define PG8_SA(b, h) (((b) * 2 + (h)) * HTB)
#define PG8_SB(b, h) ((4 + (b) * 2 + (h)) * HTB)
#define PG8_STAGE(bufoff, gbase, voff) do { _Pragma("unroll") for (int _i = 0; _i < 2; ++_i) \
        __builtin_amdgcn_global_load_lds((const unsigned*)((const char*)(gbase) + (voff)[_i]), (PG8_LAS unsigned*)(lds + (bufoff) + ldsw + _i * 8192), 16, 0, 0); } while (0)
#define PG8_LDA(dst, b, h) do { _Pragma("unroll") for (int m = 0; m < 4; ++m) _Pragma("unroll") for (int k = 0; k < 2; ++k) dst[m][k] = *(const PG8_LAS bf16x8*)(lds + PG8_SA(b, h) + aoff + m * 2048 + k * 1024); } while (0)
#define PG8_LDB(dst, b, h) do { _Pragma("unroll") for (int n = 0; n < 2; ++n) _Pragma("unroll") for (int k = 0; k < 2; ++k) dst[n][k] = *(const PG8_LAS bf16x8*)(lds + PG8_SB(b, h) + boff + n * 2048 + k * 1024); } while (0)
#define PG8_MMA(ai, bj, At, Bt) do { __builtin_amdgcn_s_setprio(1); _Pragma("unroll") for (int m = 0; m < 4; ++m) _Pragma("unroll") for (int n = 0; n < 2; ++n) _Pragma("unroll") for (int k = 0; k < 2; ++k) \
        acc[ai][bj][m][n] = __builtin_amdgcn_mfma_f32_16x16x32_bf16(Bt[n][k], At[m][k], acc[ai][bj][m][n], 0, 0, 0); __builtin_amdgcn_s_setprio(0); } while (0)
#define PG8_WAIT_V(n) asm volatile("s_waitcnt vmcnt(" #n ")" ::: "memory")
#define PG8_WAIT_L(n) asm volatile("s_waitcnt lgkmcnt(" #n ")" ::: "memory")
#define PG8_BAR __builtin_amdgcn_s_barrier()
#define PG8_SCHED __builtin_amdgcn_sched_barrier(0)
    Unit cur, nxt; int ui = 0;
    if (!S.next(0, cur)) return;
    f32x4 acc[2][2][4][2];
#pragma unroll
    for (int a = 0; a < 2; ++a)
#pragma unroll
        for (int b = 0; b < 2; ++b)
#pragma unroll
            for (int m = 0; m < 4; ++m)
#pragma unroll
                for (int n = 0; n < 2; ++n) acc[a][b][m][n] = (f32x4){0.f, 0.f, 0.f, 0.f};
    bf16x8 At[4][2], B0[2][2], B1[2][2];
    const char* cA = (const char*)g.A + (size_t)cur.pm * tstep; const char* cB = (const char*)g.Bt + (size_t)cur.pn * tstep;
    S.a_ready(cur);
    if constexpr (SP2) {
        PG8_STAGE(PG8_SB(0, 0), cB, voffB); PG8_STAGE(PG8_SB(0, 1), cB + hstep, voffB); PG8_STAGE(PG8_SA(0, 0), cA, voffA); PG8_STAGE(PG8_SA(0, 1), cA + hstep, voffA);
        if (wr == 1) PG8_BAR;
        PG8_WAIT_V(2); PG8_BAR;
        PG8_STAGE(PG8_SB(1, 0), cB + kstep, voffB); PG8_STAGE(PG8_SA(1, 0), cA + kstep, voffA); PG8_STAGE(PG8_SB(1, 1), cB + hstep + kstep, voffB);
        PG8_WAIT_V(6); PG8_BAR;
    } else {
        PG8_STAGE(PG8_SB(0, 0), cB, voffB); PG8_STAGE(PG8_SA(0, 0), cA, voffA); PG8_STAGE(PG8_SB(0, 1), cB + hstep, voffB); PG8_STAGE(PG8_SA(0, 1), cA + hstep, voffA);
        if (wr == 1) PG8_BAR;
        PG8_WAIT_V(4); PG8_BAR;
        PG8_STAGE(PG8_SB(1, 0), cB + kstep, voffB); PG8_STAGE(PG8_SA(1, 0), cA + kstep, voffA); PG8_STAGE(PG8_SB(1, 1), cB + hstep + kstep, voffB);
        PG8_WAIT_V(6); PG8_BAR;
    }
    for (;;) {
        const bool has_next = S.next(ui + 1, nxt);
        const char* nA = has_next ? (const char*)g.A + (size_t)nxt.pm * tstep : cA; const char* nB = has_next ? (const char*)g.Bt + (size_t)nxt.pn * tstep : cB;
        for (int t = 0; t < nt; t += 2) {
            const bool last = (t == nt - 2);
            const char* a1 = cA + (size_t)(t + 1) * kstep;
            const char* a2 = last ? nA : cA + (size_t)(t + 2) * kstep; const char* b2 = last ? nB : cB + (size_t)(t + 2) * kstep;
            const char* a3 = a2 + kstep; const char* b3 = b2 + kstep;
            if (last && has_next) S.a_ready(nxt);
            if constexpr (SP2) {
            PG8_LDB(B0, 0, 0); PG8_LDB(B1, 0, 1); PG8_SCHED; PG8_LDA(At, 0, 0); PG8_STAGE(PG8_SA(1, 1), a1 + hstep, voffA);
            PG8_WAIT_V(8); PG8_WAIT_L(0); PG8_BAR; PG8_MMA(0, 0, At, B0); PG8_MMA(0, 1, At, B1); PG8_BAR; PG8_SCHED;
            PG8_LDA(At, 0, 1); PG8_STAGE(PG8_SB(0, 0), b2, voffB); PG8_STAGE(PG8_SB(0, 1), b2 + hstep, voffB); PG8_STAGE(PG8_SA(0, 0), a2, voffA);
            PG8_WAIT_V(8); PG8_WAIT_L(0); PG8_BAR; PG8_MMA(1, 0, At, B0); PG8_MMA(1, 1, At, B1); PG8_BAR; PG8_SCHED;
            PG8_LDB(B0, 1, 0); PG8_LDB(B1, 1, 1); PG8_SCHED; PG8_LDA(At, 1, 0); PG8_STAGE(PG8_SA(0, 1), a2 + hstep, voffA);
            PG8_WAIT_V(8); PG8_WAIT_L(0); PG8_BAR; PG8_MMA(0, 0, At, B0); PG8_MMA(0, 1, At, B1); PG8_BAR; PG8_SCHED;
            PG8_LDA(At, 1, 1); PG8_STAGE(PG8_SB(1, 0), b3, voffB); PG8_STAGE(PG8_SB(1, 1), b3 + hstep, voffB); PG8_STAGE(PG8_SA(1, 0), a3, voffA);
            PG8_WAIT_V(8); PG8_WAIT_L(0); PG8_BAR; PG8_MMA(1, 0, At, B0); PG8_MMA(1, 1, At, B1); PG8_BAR; PG8_SCHED;
            } else {
            PG8_LDB(B0, 0, 0); PG8_SCHED; PG8_LDA(At, 0, 0); PG8_STAGE(PG8_SA(1, 1), a1 + hstep, voffA);
            PG8_WAIT_L(8); PG8_BAR; PG8_WAIT_L(0); PG8_MMA(0, 0, At, B0); PG8_BAR; PG8_SCHED;
            PG8_LDB(B1, 0, 1); PG8_STAGE(PG8_SB(0, 0), b2, voffB);
            PG8_BAR; PG8_WAIT_L(0); PG8_MMA(0, 1, At, B1); PG8_BAR;
            PG8_LDA(At, 0, 1); PG8_STAGE(PG8_SA(0, 0), a2, voffA);
            PG8_BAR; PG8_WAIT_L(0); PG8_MMA(1, 0, At, B0); PG8_BAR; PG8_SCHED;
            PG8_STAGE(PG8_SB(0, 1), b2 + hstep, voffB);
            PG8_WAIT_V(6); PG8_BAR; PG8_MMA(1, 1, At, B1); PG8_BAR;
            PG8_LDB(B0, 1, 0); PG8_SCHED; PG8_LDA(At, 1, 0); PG8_STAGE(PG8_SA(0, 1), a2 + hstep, voffA);
            PG8_WAIT_L(8); PG8_BAR; PG8_WAIT_L(0); PG8_MMA(0, 0, At, B0); PG8_BAR; PG8_SCHED;
            PG8_LDB(B1, 1, 1); PG8_STAGE(PG8_SB(1, 0), b3, voffB);
            PG8_BAR; PG8_WAIT_L(0); PG8_MMA(0, 1, At, B1); PG8_BAR;
            PG8_LDA(At, 1, 1); PG8_STAGE(PG8_SA(1, 0), a3, voffA);
            PG8_BAR; PG8_WAIT_L(0); PG8_MMA(1, 0, At, B0); PG8_BAR; PG8_SCHED;
            PG8_STAGE(PG8_SB(1, 1), b3 + hstep, voffB);
            PG8_WAIT_V(6); PG8_BAR; PG8_MMA(1, 1, At, B1); PG8_BAR;
            }
        }
        if constexpr (ALIGN_EPI) { if (wr == 0) PG8_BAR; }
        if constexpr (!Epi::AFTER_DRAIN) { E(acc, cur, wr, wc, fr, fq); S.done(cur); }
        if (!has_next) break;
#pragma unroll
        for (int a = 0; a < 2; ++a)
#pragma unroll
            for (int b = 0; b < 2; ++b)
#pragma unroll
                for (int m = 0; m < 4; ++m)
#pragma unroll
                    for (int n = 0; n < 2; ++n) acc[a][b][m][n] = (f32x4){0.f, 0.f, 0.f, 0.f};
        cur = nxt; cA = nA; cB = nB; ++ui;
        if constexpr (ALIGN_EPI) { if (wr == 1) PG8_BAR; }
    }
    PG8_WAIT_V(0);
    if constexpr (!ALIGN_EPI) { if (wr == 0) PG8_BAR; }
    PG8_BAR;
    if constexpr (Epi::AFTER_DRAIN) { E.fused(acc, cur, wr, wc, fr, fq, lds, wid, lane); S.done(cur); }
#undef PG8_SA
#undef PG8_SB
#undef PG8_STAGE
#undef PG8_LDA
#undef PG8_LDB
#undef PG8_MMA
#undef PG8_WAIT_V
#undef PG8_WAIT_L
#undef PG8_BAR
#undef PG8_SCHED
}
}

__device__ __forceinline__ int wcol_of_n(int n) {
    if (n < 1304) return n;
    if (n < 1536) return -1;
    return n - 232;
}
__device__ void p0_prologue(const Args& a, float* lds) {
    const int tid = threadIdx.x, lane = tid & 63, wave = __builtin_amdgcn_readfirstlane(tid >> 6);
    const int gw = blockIdx.x * NWAVE + wave, ngw = gridDim.x * NWAVE;
    const int gt = blockIdx.x * NTHR + tid, ngt = gridDim.x * NTHR;
    bf16* H = (bf16*)(a.ws + WS_H);
    for (int row = gw; row < NTOK; row += ngw) {
        const float4* xr = (const float4*)(a.x + (size_t)row * DM) + lane;
        const float4* gr = (const float4*)a.pre_g + lane;
        float4 v[4]; float s = 0.f;
#pragma unroll
        for (int j = 0; j < 4; ++j) { v[j] = xr[64 * j]; s += v[j].x * v[j].x + v[j].y * v[j].y + v[j].z * v[j].z + v[j].w * v[j].w; }
        s = wave_sum(s);
        const float rinv = rsqrtf(s * (1.f / DM) + RMS_EPS);
        uint2* o = (uint2*)(H + (size_t)row * DM) + lane;
#pragma unroll
        for (int j = 0; j < 4; ++j) { const float4 g = gr[64 * j];
            uint2 w; w.x = pk2(v[j].x * rinv * g.x, v[j].y * rinv * g.y); w.y = pk2(v[j].z * rinv * g.z, v[j].w * rinv * g.w); o[64 * j] = w; }
    }
    bf16* WT = (bf16*)(a.ws + WS_WTIN);
    for (int it = gt; it < NP * (DM / 8); it += ngt) {
        const int n = it % NP, kc = it / NP, k0 = kc * 8;
        const int c = wcol_of_n(n);
        float f[8];
#pragma unroll
        for (int i = 0; i < 8; ++i) f[i] = (c >= 0) ? a.w_in[(size_t)(k0 + i) * D_IN + c] : 0.f;
        uint4 w; w.x = pk2(f[0], f[1]); w.y = pk2(f[2], f[3]); w.z = pk2(f[4], f[5]); w.w = pk2(f[6], f[7]);
        *(uint4*)(WT + (size_t)n * DM + k0) = w;
    }
    float* RT = (float*)(a.ws + WS_ROPE);
    for (int it = gt; it < NTOK * 8; it += ngt) {
        const int tok = it >> 3, i = it & 7;
        const float inv[8] = {1.0f, 0.193922758102417f, 0.03760603070259094f, 0.00729266507551074f, 0.001414213445968926f,
                              0.00027424818836152554f, 5.318296462064609e-05f, 1.0313385246263351e-05f};
        float iv = inv[0];
#pragma unroll
        for (int q = 1; q < 8; ++q) iv = (i == q) ? inv[q] : iv;
        const float ang = (float)a.pos[tok] * iv;
        RT[tok * 16 + i] = cosf(ang); RT[tok * 16 + 8 + i] = sinf(ang);
    }
    if (blockIdx.x < 16) {
        const int m = blockIdx.x >> 3, n0 = (blockIdx.x & 7) * 32, nn = tid & 31, ks = tid >> 5;
        const float* pe = m ? a.cv_pos : a.ck_pos; const float* w1 = m ? a.cv_w1 : a.ck_w1;
        float acc = 0.f;
        for (int k = ks * 128; k < ks * 128 + 128; ++k) acc += pe[k] * w1[(size_t)k * 256 + n0 + nn];
        lds[ks * 32 + nn] = acc;
        __syncthreads();
        if (tid < 32) { float s = 0.f; for (int q = 0; q < 16; ++q) s += lds[q * 32 + tid]; ((float*)(a.ws + WS_CMPB))[m * 256 + n0 + tid] = s; }
        __syncthreads();
    }
}

__device__ __forceinline__ void epi16(const Args& a, int row, int n16, float (&v)[16]) {
    if (n16 >= C_GATE && n16 < C_ZA) {
        if (n16 >= 1304) return;
        float* G = (float*)(a.ws + WS_GATE) + (size_t)row * 24;
#pragma unroll
        for (int i = 0; i < 16; ++i) { const int gi = n16 - C_GATE + i; if (gi < 24) G[gi] = sigmoid_f(v[i]); }
        return;
    }
    const bool isq = (n16 < C_KCMP) || (n16 >= C_QB && n16 < C_KB);
    const bool isz = (n16 >= C_ZA && n16 < C_QB) || (n16 >= C_ZB);
    const bool isk = (n16 >= C_KCMP && n16 < C_VCMP) || (n16 >= C_KSLC && n16 < C_VSLC) || (n16 >= C_KWIN && n16 < C_VWIN) || (n16 >= C_KB && n16 < C_VB);
    if ((isq || isk) && (n16 & 63) == 0) {
        const float* rt = (const float*)(a.ws + WS_ROPE) + (size_t)row * 16;
#pragma unroll
        for (int i = 0; i < 8; ++i) { const float c = rt[i], s = rt[8 + i], x1 = v[i], x2 = v[8 + i]; v[i] = x1 * c - x2 * s; v[8 + i] = x2 * c + x1 * s; }
    }
    if (isq) {
#pragma unroll
        for (int i = 0; i < 16; ++i) v[i] *= C2;
    }
    if (isz) {
#pragma unroll
        for (int i = 0; i < 16; ++i) v[i] = silu_f(v[i]);
    }
    bf16* P = (bf16*)(a.ws + WS_PROJ) + (size_t)row * NP + n16;
    uint4 w0, w1;
    w0.x = pk2(v[0], v[1]); w0.y = pk2(v[2], v[3]); w0.z = pk2(v[4], v[5]); w0.w = pk2(v[6], v[7]);
    w1.x = pk2(v[8], v[9]); w1.y = pk2(v[10], v[11]); w1.z = pk2(v[12], v[13]); w1.w = pk2(v[14], v[15]);
    ((uint4*)P)[0] = w0; ((uint4*)P)[1] = w1;
}
__device__ void p1_naive(const Args& a, float* lds) {
    const int tid = threadIdx.x, tx = tid & 15, ty = tid >> 4;
    float* As = lds;
    float* Bs = lds + 32 * 64;
    const bf16* H = (const bf16*)(a.ws + WS_H); const bf16* WT = (const bf16*)(a.ws + WS_WTIN);
    for (int tile = blockIdx.x; tile < (NTOK / 64) * (NP / 256); tile += gridDim.x) {
        const int pm = tile / (NP / 256), pn = tile % (NP / 256);
        const int row0 = pm * 64, n0 = pn * 256;
        float acc[2][16];
#pragma unroll
        for (int r = 0; r < 2; ++r)
#pragma unroll
            for (int c = 0; c < 16; ++c) acc[r][c] = 0.f;
        for (int k0 = 0; k0 < DM; k0 += 32) {
            { const int r = tid >> 3, kq = (tid & 7) * 4;
              const uint2 w = *(const uint2*)(H + (size_t)(row0 + r) * DM + k0 + kq);
              As[(kq + 0) * 64 + r] = bflo(w.x); As[(kq + 1) * 64 + r] = bfhi(w.x); As[(kq + 2) * 64 + r] = bflo(w.y); As[(kq + 3) * 64 + r] = bfhi(w.y); }
            { const int n = tid >> 1, kh = (tid & 1) * 16;
              const uint4 w0 = *(const uint4*)(WT + (size_t)(n0 + n) * DM + k0 + kh);
              const uint4 w1 = *(const uint4*)(WT + (size_t)(n0 + n) * DM + k0 + kh + 8);
              float* b = Bs + kh * 256 + n;
              b[0 * 256] = bflo(w0.x); b[1 * 256] = bfhi(w0.x); b[2 * 256] = bflo(w0.y); b[3 * 256] = bfhi(w0.y);
              b[4 * 256] = bflo(w0.z); b[5 * 256] = bfhi(w0.z); b[6 * 256] = bflo(w0.w); b[7 * 256] = bfhi(w0.w);
              b[8 * 256] = bflo(w1.x); b[9 * 256] = bfhi(w1.x); b[10 * 256] = bflo(w1.y); b[11 * 256] = bfhi(w1.y);
              b[12 * 256] = bflo(w1.z); b[13 * 256] = bfhi(w1.z); b[14 * 256] = bflo(w1.w); b[15 * 256] = bfhi(w1.w); }
            __syncthreads();
#pragma unroll 4
            for (int k = 0; k < 32; ++k) {
                const float a0 = As[k * 64 + 2 * ty], a1 = As[k * 64 + 2 * ty + 1];
                const float4* bp = (const float4*)(Bs + k * 256 + 16 * tx);
                const float4 b0 = bp[0], b1 = bp[1], b2 = bp[2], b3 = bp[3];
                const float bb[16] = {b0.x, b0.y, b0.z, b0.w, b1.x, b1.y, b1.z, b1.w, b2.x, b2.y, b2.z, b2.w, b3.x, b3.y, b3.z, b3.w};
#pragma unroll
                for (int c = 0; c < 16; ++c) { acc[0][c] += a0 * bb[c]; acc[1][c] += a1 * bb[c]; }
            }
            __syncthreads();
        }
        epi16(a, row0 + 2 * ty, n0 + 16 * tx, acc[0]);
        epi16(a, row0 + 2 * ty + 1, n0 + 16 * tx, acc[1]);
    }
}

template <int R> struct WAttn {
    float m[R], l[R], o[R];
    __device__ __forceinline__ void init() {
#pragma unroll
        for (int r = 0; r < R; ++r) { m[r] = -INFINITY; l[r] = 0.f; o[r] = 0.f; }
    }
    __device__ __forceinline__ void scores(const float* qs, const bf16* krow, float (&s)[R]) {
#pragma unroll
        for (int r = 0; r < R; ++r) s[r] = 0.f;
        uint4 kc = ((const uint4*)krow)[0];
#pragma unroll 1
        for (int i = 0; i < 8; ++i) {
            const uint4 kn = ((const uint4*)krow)[i < 7 ? i + 1 : 7];
            const float k0 = bflo(kc.x), k1 = bfhi(kc.x), k2 = bflo(kc.y), k3 = bfhi(kc.y), k4 = bflo(kc.z), k5 = bfhi(kc.z), k6 = bflo(kc.w), k7 = bfhi(kc.w);
#pragma unroll
            for (int r = 0; r < R; ++r) {
                const float4 q0 = *(const float4*)(qs + r * 64 + i * 8), q1 = *(const float4*)(qs + r * 64 + i * 8 + 4);
                s[r] += q0.x * k0 + q0.y * k1 + q0.z * k2 + q0.w * k3 + q1.x * k4 + q1.y * k5 + q1.z * k6 + q1.w * k7;
            }
            kc = kn;
        }
    }
    __device__ __forceinline__ void chunk(const float* qs, const bf16* krow, const bf16* vrow, bool valid, int lane) {
        float s[R]; scores(qs, krow, s);
        float p[R];
#pragma unroll
        for (int r = 0; r < R; ++r) {
            const float sv = valid ? s[r] : -INFINITY;
            const float mx = wave_max(sv);
            const float mn = fmaxf(m[r], mx);
            float alpha = 1.f, pv = 0.f;
            if (mn > -INFINITY) { alpha = exp2f(m[r] - mn); pv = valid ? exp2f(sv - mn) : 0.f; }
            l[r] = l[r] * alpha + wave_sum(pv); o[r] *= alpha; m[r] = mn; p[r] = pv;
        }
        const unsigned long long vaddr = (unsigned long long)vrow;
#pragma unroll 4
        for (int key = 0; key < 64; ++key) {
            const unsigned long long va = __shfl(vaddr, key);
            const float vv = bf2f(((const bf16*)va)[lane]);
#pragma unroll
            for (int r = 0; r < R; ++r) o[r] += __shfl(p[r], key) * vv;
        }
    }
};

__device__ void p2_compress(const Args& a, float* lds_wave, int item, int lane) {
    const int prob = item >> 6, cg8 = item & 63, kv = prob & 1, bg = prob >> 1, b = bg >> 1, g = bg & 1;
    const int c0 = cg8 * 8;
    const float* w1 = kv ? a.cv_w1 : a.ck_w1; const float* w2 = kv ? a.cv_w2 : a.ck_w2;
    const float* bias = (const float*)(a.ws + WS_CMPB) + kv * 256;
    const bf16* src = (const bf16*)(a.ws + WS_PROJ) + (size_t)b * SEQ * NP + (kv ? C_VCMP : C_KCMP) + g * 64;
    float acc[8][4];
#pragma unroll
    for (int c = 0; c < 8; ++c)
#pragma unroll
        for (int i = 0; i < 4; ++i) acc[c][i] = 0.f;
    for (int k = 0; k < 2048; ++k) {
        const int tok_off = k >> 6, d = k & 63;
        float w[4];
#pragma unroll
        for (int i = 0; i < 4; ++i) w[i] = w1[(size_t)k * 256 + lane + 64 * i];
#pragma unroll
        for (int c = 0; c < 8; ++c) {
            int tok = 16 * (c0 + c) + tok_off; tok = tok < SEQ ? tok : SEQ - 1;
            const float av = bf2f(src[(size_t)tok * NP + d]);
#pragma unroll
            for (int i = 0; i < 4; ++i) acc[c][i] += av * w[i];
        }
    }
#pragma unroll
    for (int c = 0; c < 8; ++c)
#pragma unroll
        for (int i = 0; i < 4; ++i) lds_wave[c * 256 + lane + 64 * i] = silu_f(acc[c][i] + bias[lane + 64 * i]);
    __builtin_amdgcn_s_waitcnt(0xc07f);
    asm volatile("" ::: "memory");
    float out[8];
#pragma unroll
    for (int c = 0; c < 8; ++c) out[c] = 0.f;
    for (int n = 0; n < 256; ++n) {
        const float w = w2[n * 64 + lane];
#pragma unroll
        for (int c = 0; c < 8; ++c) out[c] += lds_wave[c * 256 + n] * w;
    }
    bf16* dst = (bf16*)(a.ws + (kv ? WS_VC : WS_KC)) + (size_t)bg * 512 * 64;
#pragma unroll
    for (int c = 0; c < 8; ++c) dst[(size_t)(c0 + c) * 64 + lane] = (bf16)((c0 + c) < 511 ? f2bf(out[c]) : 0u);
    asm volatile("" ::: "memory");
}
__device__ void p2_dilated(const Args& a, float* qs, int item, int lane) {
    const int h = item & 7, tok = (item >> 3) & (NTOK - 1), p = item >> 17;
    const int b = tok >> 13, t = tok & (SEQ - 1);
    const int dil = (p == 0) ? 1 : (p == 1) ? 4 : 16, sh = (p == 0) ? 0 : (p == 1) ? 2 : 4;
    const bf16* P = (const bf16*)(a.ws + WS_PROJ);
    qs[lane] = bf2f(P[(size_t)tok * NP + C_QB + h * 64 + lane]);
    __builtin_amdgcn_s_waitcnt(0xc07f); asm volatile("" ::: "memory");
    const int i = t >> sh, r = t & (dil - 1);
    WAttn<1> A; A.init();
    for (int c = 0; c < 3; ++c) {
        const int jd = i - 191 + 64 * c + lane;
        const bool valid = (jd >= 0) && (jd >= i - 128) && (jd <= i);
        const int jc = jd < 0 ? 0 : jd;
        const size_t krow = (size_t)(b * SEQ + jc * dil + r) * NP;
        A.chunk(qs, P + krow + C_KB + h * 64, P + krow + C_VB + h * 64, valid, lane);
    }
    bf16* OB = (bf16*)(a.ws + WS_OB) + (size_t)p * NTOK * 512;
    OB[(size_t)tok * 512 + h * 64 + lane] = (bf16)f2bf(A.o[0] / A.l[0]);
    if (lane == 0) ((float*)(a.ws + WS_LSEB))[((size_t)p * NTOK + tok) * 8 + h] = A.m[0] + log2f(A.l[0]);
    asm volatile("" ::: "memory");
}

__device__ void p3_combine(const Args& a, int tok, int lane) {
    const int h = lane >> 3;
    const float* L = (const float*)(a.ws + WS_LSEB);
    const float l0 = L[((size_t)0 * NTOK + tok) * 8 + h], l1 = L[((size_t)1 * NTOK + tok) * 8 + h], l2 = L[((size_t)2 * NTOK + tok) * 8 + h];
    const float mx = fmaxf(l0, fmaxf(l1, l2));
    float w0 = exp2f(l0 - mx), w1 = exp2f(l1 - mx), w2 = exp2f(l2 - mx);
    const float inv = 1.f / (w0 + w1 + w2); w0 *= inv; w1 *= inv; w2 *= inv;
    const bf16* OB = (const bf16*)(a.ws + WS_OB);
    const uint4 o0 = *(const uint4*)(OB + ((size_t)0 * NTOK + tok) * 512 + lane * 8);
    const uint4 o1 = *(const uint4*)(OB + ((size_t)1 * NTOK + tok) * 512 + lane * 8);
    const uint4 o2 = *(const uint4*)(OB + ((size_t)2 * NTOK + tok) * 512 + lane * 8);
    const uint4 z = *(const uint4*)((const bf16*)(a.ws + WS_PROJ) + (size_t)tok * NP + C_ZB + lane * 8);
    uint4 r;
#define CMB(f) r.f = pk2((w0 * bflo(o0.f) + w1 * bflo(o1.f) + w2 * bflo(o2.f)) * bflo(z.f), (w0 * bfhi(o0.f) + w1 * bfhi(o1.f) + w2 * bfhi(o2.f)) * bfhi(z.f))
    CMB(x); CMB(y); CMB(z); CMB(w);
#undef CMB
    *(uint4*)((bf16*)(a.ws + WS_H) + (size_t)tok * DM + 512 + lane * 8) = r;
}
__device__ void p3_mixer_a(const Args& a, float* qs, float* imp, int item, int lane) {
    const int g = item & 1, tok = item >> 1, b = tok >> 13, t = tok & (SEQ - 1);
    const bf16* P = (const bf16*)(a.ws + WS_PROJ);
    const bf16* Pb = P + (size_t)b * SEQ * NP;
#pragma unroll
    for (int r = 0; r < 4; ++r) qs[r * 64 + lane] = bf2f(P[(size_t)tok * NP + C_QA + (g * 4 + r) * 64 + lane]);
#pragma unroll
    for (int i = 0; i < 8; ++i) imp[lane + 64 * i] = 0.f;
    __builtin_amdgcn_s_waitcnt(0xc07f); asm volatile("" ::: "memory");
    const float* G = (const float*)(a.ws + WS_GATE) + (size_t)tok * 24;
    float tot[4] = {0.f, 0.f, 0.f, 0.f};
    const int cur = t >> 6;
    const bf16* KC = (const bf16*)(a.ws + WS_KC) + (size_t)(b * 2 + g) * 512 * 64;
    const bf16* VC = (const bf16*)(a.ws + WS_VC) + (size_t)(b * 2 + g) * 512 * 64;
    const int cmax = (t >= 31) ? ((t - 31) >> 4) : -1;
    const int swa_base = (t & ~63) - 512;
    unsigned long long m0 = 0ull, m1 = 0ull;
    WAttn<4> A;
#pragma unroll 1
    for (int br = 0; br < 3; ++br) {
        A.init();
        const int nch = (br == 0) ? ((cmax >= 0) ? (cmax >> 6) + 1 : 0) : (br == 1) ? cur + 1 : 9;
#pragma unroll 1
        for (int c = 0; c < nch; ++c) {
            const bf16 *kp, *vp; bool valid;
            if (br == 0) { const int cc = c * 64 + lane; kp = KC + (size_t)cc * 64; vp = VC + (size_t)cc * 64; valid = cc <= cmax; }
            else if (br == 1) {
                const bool sel = (c < 64) ? ((m0 >> c) & 1ull) : ((m1 >> (c - 64)) & 1ull);
                if (!sel) continue;
                const int key = c * 64 + lane; const size_t ro = (size_t)key * NP + g * 64;
                kp = Pb + ro + C_KSLC; vp = Pb + ro + C_VSLC; valid = key <= t;
            } else {
                if (swa_base + 64 * c + 63 < 0) continue;
                const int key = swa_base + 64 * c + lane;
                valid = key >= 0 && key <= t && (t - key) <= 511;
                const int kc2 = key < 0 ? 0 : key; const size_t ro = (size_t)kc2 * NP + g * 64;
                kp = Pb + ro + C_KWIN; vp = Pb + ro + C_VWIN;
            }
            A.chunk(qs, kp, vp, valid, lane);
        }
        float rl[4];
#pragma unroll
        for (int r = 0; r < 4; ++r) { rl[r] = (A.l[r] > 0.f) ? 1.f / A.l[r] : 0.f; tot[r] += G[br * 8 + g * 4 + r] * A.o[r] * rl[r]; }
        if (br == 0) {
#pragma unroll 1
            for (int c = 0; c < nch; ++c) {
                const int cc = c * 64 + lane; float s[4]; A.scores(qs, KC + (size_t)cc * 64, s);
                float ip = 0.f;
#pragma unroll
                for (int r = 0; r < 4; ++r) ip += (cc <= cmax) ? exp2f(s[r] - A.m[r]) * rl[r] : 0.f;
                imp[cc] = ip;
            }
            __builtin_amdgcn_s_waitcnt(0xc07f); asm volatile("" ::: "memory");
            float sc[2];
#pragma unroll
            for (int q = 0; q < 2; ++q) {
                const int j = lane + 64 * q;
                float v = (j > 0 ? imp[4 * j - 1] : 0.f) + 2.f * imp[4 * j] + 2.f * imp[4 * j + 1] + 2.f * imp[4 * j + 2] + imp[4 * j + 3];
                if (j == 0 || j == cur || j == cur - 1) v = 1e4f;
                if (j > cur) v = -1.f;
                sc[q] = v;
            }
#pragma unroll 1
            for (int it = 0; it < 16; ++it) {
                float bv; int bi;
                if (sc[0] >= sc[1]) { bv = sc[0]; bi = lane; } else { bv = sc[1]; bi = lane + 64; }
#pragma unroll
                for (int off = 32; off >= 1; off >>= 1) {
                    const float ov = __shfl_xor(bv, off); const int oi = __shfl_xor(bi, off);
                    if (ov > bv || (ov == bv && oi < bi)) { bv = ov; bi = oi; }
                }
                bi = __builtin_amdgcn_readfirstlane(bi);
                if (bi <= cur) { if (bi < 64) m0 |= 1ull << bi; else m1 |= 1ull << (bi - 64); }
                if (bi == lane) sc[0] = -2.f;
                if (bi == lane + 64) sc[1] = -2.f;
            }
        }
    }
    bf16* MX = (bf16*)(a.ws + WS_H) + (size_t)tok * DM;
#pragma unroll
    for (int r = 0; r < 4; ++r) { const int col = (g * 4 + r) * 64 + lane; MX[col] = (bf16)f2bf(tot[r] * bf2f(P[(size_t)tok * NP + C_ZA + col])); }
    asm volatile("" ::: "memory");
}


namespace mxa {
#define MXA_LAS __attribute__((address_space(3)))
typedef short bf16x8 __attribute__((ext_vector_type(8)));
typedef short s16x4 __attribute__((ext_vector_type(4)));
typedef float f32x16 __attribute__((ext_vector_type(16)));
typedef unsigned u32x4 __attribute__((ext_vector_type(4)));
typedef float f32x2_t __attribute__((ext_vector_type(2))); typedef __bf16 bf16x2_t __attribute__((ext_vector_type(2)));
typedef MXA_LAS const char* lds_cptr;
constexpr int SLOT = 16384;
constexpr int L_SC = 32768;
constexpr int L_MASK = 65536;
constexpr int L_WSF = 66560;
constexpr int L_TOT = 69632;
__device__ __forceinline__ int crow(int r, int hi) { return (r & 3) + 8 * (r >> 2) + 4 * hi; }
__device__ __forceinline__ unsigned cvtpk(float lo, float hi) { f32x2_t v = {lo, hi}; bf16x2_t b = __builtin_convertvector(v, bf16x2_t); return __builtin_bit_cast(unsigned, b); }
__device__ __forceinline__ s16x4 vtr(lds_cptr p) { typedef short v4i16_t __attribute__((ext_vector_type(4))); return __builtin_bit_cast(s16x4, __builtin_amdgcn_ds_read_tr16_b64_v4i16((MXA_LAS v4i16_t*)p)); }
__device__ __forceinline__ float ex2(float v) { return __builtin_amdgcn_exp2f(v); }

__device__ __forceinline__ void qkt(f32x16& p0, f32x16& p1, lds_cptr Ks, const bf16x8 (&qr)[4], int r32, int hi) {
    lds_cptr kb = Ks + hi * 1024 + r32 * 16;
    p0 = f32x16{}; p1 = f32x16{};
#pragma unroll
    for (int d0 = 0; d0 < 4; ++d0) {
        const bf16x8 b0 = *(const MXA_LAS bf16x8*)(kb + d0 * 2048);
        const bf16x8 b1 = *(const MXA_LAS bf16x8*)(kb + d0 * 2048 + 512);
        p0 = __builtin_amdgcn_mfma_f32_32x32x16_bf16(b0, qr[d0], p0, 0, 0, 0);
        p1 = __builtin_amdgcn_mfma_f32_32x32x16_bf16(b1, qr[d0], p1, 0, 0, 0);
    }
}
__device__ __forceinline__ float sel_ninf(float x, int d) {
    const unsigned mk = (unsigned)(d >> 31);
    return __builtin_bit_cast(float, (__builtin_bit_cast(unsigned, x) & ~mk) | (0xff800000u & mk));
}
__device__ __forceinline__ void mask_le(f32x16& p0, f32x16& p1, int thr, int hi) {
    const int t0 = thr - 4 * hi;
#pragma unroll
    for (int r = 0; r < 16; ++r) { const int c = (r & 3) + 8 * (r >> 2); p0[r] = sel_ninf(p0[r], t0 - c); p1[r] = sel_ninf(p1[r], t0 - c - 32); }
}
__device__ __forceinline__ void mask_ge(f32x16& p0, f32x16& p1, int thr, int hi) {
    const int t0 = 4 * hi - thr;
#pragma unroll
    for (int r = 0; r < 16; ++r) { const int c = (r & 3) + 8 * (r >> 2); p0[r] = sel_ninf(p0[r], t0 + c); p1[r] = sel_ninf(p1[r], t0 + c + 32); }
}
__device__ __forceinline__ float rowmax32(const f32x16& p0, const f32x16& p1) {
    float a = fmaxf(p0[0], p1[0]);
#pragma unroll
    for (int r = 1; r < 16; ++r) a = fmaxf(a, fmaxf(p0[r], p1[r]));
    return fmaxf(a, __shfl_xor(a, 32));
}
__device__ __forceinline__ void softmax_pv(f32x16& p0, f32x16& p1, float& m, float& lsum, f32x16 (&o)[2], lds_cptr Vs, MXA_LAS float* wsf, int lane, int r32, int hi) {
    const float rm = rowmax32(p0, p1);
    const float mn = fmaxf(m, rm);
    const float ms = (mn == -INFINITY) ? 0.f : mn;
    const float alpha = ex2(m - ms);
    float rs = 0.f;
#pragma unroll
    for (int r = 0; r < 16; ++r) { p0[r] = ex2(p0[r] - ms); p1[r] = ex2(p1[r] - ms); rs += p0[r] + p1[r]; }
    lsum = lsum * alpha + rs; m = mn;
    if (__any(alpha != 1.f)) {
        if (hi == 0) wsf[r32] = alpha;
        asm volatile("s_waitcnt lgkmcnt(0)" ::: "memory");
#pragma unroll
        for (int r = 0; r < 16; ++r) { const float f = wsf[crow(r, hi)]; o[0][r] *= f; o[1][r] *= f; }
        asm volatile("s_waitcnt lgkmcnt(0)" ::: "memory");
    }
    u32x4 pw[4];
#pragma unroll
    for (int k = 0; k < 4; ++k) {
        pw[0][k] = cvtpk(p0[2 * k], p0[2 * k + 1]); pw[1][k] = cvtpk(p0[8 + 2 * k], p0[8 + 2 * k + 1]);
        pw[2][k] = cvtpk(p1[2 * k], p1[2 * k + 1]); pw[3][k] = cvtpk(p1[8 + 2 * k], p1[8 + 2 * k + 1]);
    }
    lds_cptr vp = Vs + ((lane >> 4) & 1) * 32 + (lane & 3) * 8 + (4 * hi + ((lane & 15) >> 2)) * 64;
#pragma unroll
    for (int dh = 0; dh < 2; ++dh)
#pragma unroll
        for (int ks = 0; ks < 4; ++ks) {
            const s16x4 lo = vtr(vp + dh * 4096 + ks * 1024), hh = vtr(vp + dh * 4096 + ks * 1024 + 512);
            const bf16x8 vf = {lo[0], lo[1], lo[2], lo[3], hh[0], hh[1], hh[2], hh[3]};
            o[dh] = __builtin_amdgcn_mfma_f32_32x32x16_bf16(__builtin_bit_cast(bf16x8, pw[ks]), vf, o[dh], 0, 0, 0);
        }
}

__device__ __forceinline__ void unit(const Args& a, unsigned char* lds_raw, int b, int g, int T) {
    const int tid = threadIdx.x, lane = tid & 63, w = __builtin_amdgcn_readfirstlane(tid >> 6), r32 = lane & 31, hi = lane >> 5;
    MXA_LAS char* L = (MXA_LAS char*)lds_raw;
    MXA_LAS float* wsf = (MXA_LAS float*)(L + L_WSF) + w * 64;
    MXA_LAS float* SC = (MXA_LAS float*)(L + L_SC);
    MXA_LAS unsigned* MK = (MXA_LAS unsigned*)(L + L_MASK);
    const bf16* P = (const bf16*)(a.ws + WS_PROJ);
    const bf16* Pb = P + (size_t)b * SEQ * NP;
    const int a_i = 8 * w + (r32 >> 2);
    const int head = g * 4 + (r32 & 3);
    const int t_i = 64 * T + a_i;
    bf16x8 qr[4];
    { const bf16* qrow = Pb + (size_t)t_i * NP + C_QA + head * 64;
#pragma unroll
      for (int d0 = 0; d0 < 4; ++d0) qr[d0] = *(const bf16x8*)(qrow + d0 * 16 + hi * 8); }
    const float* G = (const float*)(a.ws + WS_GATE) + (size_t)(b * SEQ + t_i) * 24;
    const int cmax_i = (t_i >= 31) ? ((t_i - 31) >> 4) : -1;
    const int cm_min = (T > 0) ? (4 * T - 2) : -1;
    const int ntc = ((4 * T + 2) >> 6) + 1;
    MXA_LAS float* TOT = (MXA_LAS float*)(L + L_TOT) + w * 2048 + lane;
    unsigned mk0 = 0, mk1 = 0, mk2 = 0, mk3 = 0;
    const int vkey = 16 * (w & 3) + (lane >> 2), vcol = (w >> 2) * 32 + (lane & 3) * 8;
    const unsigned sdst = (unsigned)(w * 1024 + lane * 16);
#pragma unroll 1
    for (int br = 0; br < 3; ++br) {
        const bf16* Kb; const bf16* Vb; size_t pitch; int tile0, nt;
        if (br == 0) { Kb = (const bf16*)(a.ws + WS_KC) + (size_t)(b * 2 + g) * 512 * 64; Vb = (const bf16*)(a.ws + WS_VC) + (size_t)(b * 2 + g) * 512 * 64; pitch = 64; tile0 = 0; nt = ntc; }
        else if (br == 1) { Kb = Pb + C_KSLC + g * 64; Vb = Pb + C_VSLC + g * 64; pitch = NP; tile0 = 0; nt = T + 1; }
        else { Kb = Pb + C_KWIN + g * 64; Vb = Pb + C_VWIN + g * 64; pitch = NP; tile0 = (T >= 8) ? T - 8 : 0; nt = T - tile0 + 1; }
        float m = -INFINITY, lsum = 0.f; f32x16 o[2]; o[0] = f32x16{}; o[1] = f32x16{};
        const bf16* ksrc = Kb + (size_t)lane * pitch + w * 8;
        const bf16* vsrc = Vb + (size_t)vkey * pitch + vcol;
        u32x4 kreg = *(const u32x4*)(ksrc + (size_t)tile0 * 64 * pitch), vreg = *(const u32x4*)(vsrc + (size_t)tile0 * 64 * pitch);
        *(MXA_LAS u32x4*)(L + sdst) = kreg; *(MXA_LAS u32x4*)(L + 8192 + sdst) = vreg;
        __syncthreads();
#pragma unroll 1
        for (int n = 0; n < nt; ++n) {
            const int k = tile0 + n;
            if (n + 1 < nt) { kreg = *(const u32x4*)(ksrc + (size_t)(k + 1) * 64 * pitch); vreg = *(const u32x4*)(vsrc + (size_t)(k + 1) * 64 * pitch); }
            lds_cptr Ks = (lds_cptr)(L + (n & 1) * SLOT), Vs = Ks + 8192;
            bool sel = true;
            if (br == 1) { const unsigned wsel = (k < 32) ? mk0 : (k < 64) ? mk1 : (k < 96) ? mk2 : mk3; sel = (wsel >> (k & 31)) & 1u; }
            if (__any(sel)) {
                f32x16 p0, p1; qkt(p0, p1, Ks, qr, r32, hi);
                if (br == 0) { if (64 * k + 63 > cm_min) mask_le(p0, p1, cmax_i - 64 * k, hi); }
                else if (br == 1) { if (k == T) mask_le(p0, p1, a_i, hi); if (!sel) mask_le(p0, p1, -1, hi); }
                else { if (k == T) mask_le(p0, p1, a_i, hi); if (k == T - 8) mask_ge(p0, p1, a_i + 1, hi); }
                softmax_pv(p0, p1, m, lsum, o, Vs, wsf, lane, r32, hi);
            }
            if (n + 1 < nt) { *(MXA_LAS u32x4*)(L + ((n + 1) & 1) * SLOT + sdst) = kreg; *(MXA_LAS u32x4*)(L + ((n + 1) & 1) * SLOT + 8192 + sdst) = vreg; }
            __syncthreads();
        }
        const float ltot = lsum + __shfl_xor(lsum, 32);
        const float rl = (ltot > 0.f) ? 1.f / ltot : 0.f;
        if (hi == 0) wsf[r32] = G[br * 8 + head] * rl;
        asm volatile("s_waitcnt lgkmcnt(0)" ::: "memory");
#pragma unroll
        for (int r = 0; r < 16; ++r) { const float f = wsf[crow(r, hi)];
            if (br == 0) { TOT[(2 * r) * 64] = o[0][r] * f; TOT[(2 * r + 1) * 64] = o[1][r] * f; }
            else { TOT[(2 * r) * 64] += o[0][r] * f; TOT[(2 * r + 1) * 64] += o[1][r] * f; } }
        asm volatile("s_waitcnt lgkmcnt(0)" ::: "memory");
        if (br == 0) {
            if (T >= 16) {
                kreg = *(const u32x4*)(ksrc);
                *(MXA_LAS u32x4*)(L + sdst) = kreg;
                __syncthreads();
                float carry = 0.f;
#pragma unroll 1
                for (int n = 0; n < nt; ++n) {
                    if (n + 1 < nt) kreg = *(const u32x4*)(ksrc + (size_t)(n + 1) * 64 * pitch);
                    lds_cptr Ks = (lds_cptr)(L + (n & 1) * SLOT);
                    f32x16 p0, p1; qkt(p0, p1, Ks, qr, r32, hi);
                    if (64 * n + 63 > cm_min) mask_le(p0, p1, cmax_i - 64 * n, hi);
                    const float ms = (m == -INFINITY) ? 0.f : m;
#pragma unroll
                    for (int r = 0; r < 16; ++r) {
                        float v0 = ex2(p0[r] - ms) * rl, v1 = ex2(p1[r] - ms) * rl;
                        v0 += __shfl_xor(v0, 1); v1 += __shfl_xor(v1, 1); v0 += __shfl_xor(v0, 2); v1 += __shfl_xor(v1, 2);
                        p0[r] = v0; p1[r] = v1;
                    }
#pragma unroll
                    for (int gi = 0; gi < 8; ++gi) {
                        const int hf = gi >> 2, q4 = gi & 3;
                        const float a0 = hf ? p1[4 * q4] : p0[4 * q4], a1 = hf ? p1[4 * q4 + 1] : p0[4 * q4 + 1], a2 = hf ? p1[4 * q4 + 2] : p0[4 * q4 + 2], a3 = hf ? p1[4 * q4 + 3] : p0[4 * q4 + 3];
                        const float y = __shfl_xor(a3, 32);
                        const float prev = hi ? y : carry;
                        carry = y;
                        const float sj = 2.f * (a0 + a1 + a2) + a3 + prev;
                        const int j = 16 * n + 8 * hf + 2 * q4 + hi;
                        if ((r32 & 3) == 0) SC[a_i * 128 + j] = sj;
                    }
                    if (n + 1 < nt) *(MXA_LAS u32x4*)(L + ((n + 1) & 1) * SLOT + sdst) = kreg;
                    __syncthreads();
                }
            }
            {
                const int tk = 8 * w + (lane >> 3), sub = lane & 7;
                unsigned mw[4] = {0u, 0u, 0u, 0u};
                if (T < 16) { mw[0] = (T >= 31) ? 0xffffffffu : ((2u << T) - 1u); }
                else {
                    float v[16];
#pragma unroll
                    for (int e = 0; e < 16; ++e) { const int j = sub + 8 * e; v[e] = (j >= 1 && j <= T - 2) ? SC[tk * 128 + j] : -1.f; }
#pragma unroll 1
                    for (int it = 0; it < 13; ++it) {
                        float bv = v[0]; int bi = sub;
#pragma unroll
                        for (int e = 1; e < 16; ++e) { if (v[e] > bv) { bv = v[e]; bi = sub + 8 * e; } }
#pragma unroll
                        for (int off = 1; off < 8; off <<= 1) {
                            const float ov = __shfl_xor(bv, off); const int oi = __shfl_xor(bi, off);
                            if (ov > bv || (ov == bv && oi < bi)) { bv = ov; bi = oi; }
                        }
#pragma unroll
                        for (int e = 0; e < 16; ++e) if (bi == sub + 8 * e) v[e] = -2.f;
#pragma unroll
                        for (int q = 0; q < 4; ++q) if ((bi >> 5) == q) mw[q] |= 1u << (bi & 31);
                    }
#pragma unroll
                    for (int q = 0; q < 4; ++q) { if (q == 0) mw[q] |= 1u; if (((T - 1) >> 5) == q) mw[q] |= 1u << ((T - 1) & 31); if ((T >> 5) == q) mw[q] |= 1u << (T & 31); }
                }
                if (sub == 0) {
#pragma unroll
                    for (int q = 0; q < 4; ++q) MK[tk * 4 + q] = mw[q];
                }
                asm volatile("s_waitcnt lgkmcnt(0)" ::: "memory");
                mk0 = MK[a_i * 4 + 0]; mk1 = MK[a_i * 4 + 1]; mk2 = MK[a_i * 4 + 2]; mk3 = MK[a_i * 4 + 3];
                asm volatile("s_waitcnt lgkmcnt(0)" ::: "memory");
            }
        }
    }
    bf16* MX = (bf16*)(a.ws + WS_H);
#pragma unroll
    for (int r = 0; r < 16; ++r) {
        const int q = crow(r, hi), tok = b * SEQ + 64 * T + 8 * w + (q >> 2), hd = g * 4 + (q & 3);
#pragma unroll
        for (int dh = 0; dh < 2; ++dh) {
            const int col = hd * 64 + dh * 32 + r32;
            const float z = bf2f(P[(size_t)tok * NP + C_ZA + col]);
            MX[(size_t)tok * DM + col] = (bf16)f2bf(TOT[(2 * r + dh) * 64] * z);
        }
    }
}
}

__device__ void p4_naive(const Args& a, float* lds) {
    const int tid = threadIdx.x, lane = tid & 63, wave = __builtin_amdgcn_readfirstlane(tid >> 6);
    float* Ms = lds;
    float* red = lds + 16 * 1024;
    const bf16* MX = (const bf16*)(a.ws + WS_H);
    for (int blk = blockIdx.x; blk < NTOK / 16; blk += gridDim.x) {
        const int row0 = blk * 16;
        for (int i = tid; i < 16 * 1024 / 2; i += NTHR) { const u32 w = ((const u32*)(MX + (size_t)row0 * DM))[i]; Ms[2 * i] = bflo(w); Ms[2 * i + 1] = bfhi(w); }
        __syncthreads();
        float acc[16][2];
#pragma unroll
        for (int r = 0; r < 16; ++r) { acc[r][0] = 0.f; acc[r][1] = 0.f; }
        for (int k = 0; k < DM; ++k) {
            const float2 w = *(const float2*)(a.w_out + (size_t)k * DM + 2 * tid);
#pragma unroll
            for (int r = 0; r < 16; ++r) { const float m = Ms[r * 1024 + k]; acc[r][0] += m * w.x; acc[r][1] += m * w.y; }
        }
#pragma unroll
        for (int r = 0; r < 16; ++r) { const float s = wave_sum(acc[r][0] * acc[r][0] + acc[r][1] * acc[r][1]); if (lane == 0) red[r * 8 + wave] = s; }
        __syncthreads();
        const float2 pg = *(const float2*)(a.post_g + 2 * tid);
#pragma unroll
        for (int r = 0; r < 16; ++r) {
            float s = 0.f;
#pragma unroll
            for (int q = 0; q < 8; ++q) s += red[r * 8 + q];
            const float rinv = rsqrtf(s * (1.f / DM) + RMS_EPS);
            const float2 xv = *(const float2*)(a.x + (size_t)(row0 + r) * DM + 2 * tid);
            float2 o; o.x = xv.x + acc[r][0] * rinv * pg.x; o.y = xv.y + acc[r][1] * rinv * pg.y;
            *(float2*)(a.out + (size_t)(row0 + r) * DM + 2 * tid) = o;
        }
        __syncthreads();
    }
}

constexpr int LDS_BYTES = 147456;
__global__ void __launch_bounds__(NTHR, 2) mk_fwd(Args a) {
    extern __shared__ __attribute__((aligned(16))) unsigned char lds_raw[];
    float* lds = (float*)lds_raw;
    cg::grid_group grid = cg::this_grid();
    const int tid = threadIdx.x, lane = tid & 63, wave = __builtin_amdgcn_readfirstlane(tid >> 6);
    const int gw = blockIdx.x * NWAVE + wave, ngw = gridDim.x * NWAVE;
#define IN(k) (a.ph_lo <= (k) && (k) < a.ph_hi)
#define SEAM(k) do { if (IN(k) && IN((k) + 1)) { __threadfence(); grid.sync(); } } while (0)
    if (IN(0)) p0_prologue(a, lds);
    SEAM(0);
    if (IN(1)) {
        pg8::Gemm g{(const pg8::bf16_t*)(a.ws + WS_H), (const pg8::bf16_t*)(a.ws + WS_WTIN), NTOK, NP, DM};
        pg8::StaticOrder S; S.init(NTOK, NP, (int)gridDim.x, (int)blockIdx.x);
        pg8::EpiProj E{(pg8::bf16_t*)(a.ws + WS_PROJ), (float*)(a.ws + WS_GATE), (const float*)(a.ws + WS_ROPE), C2};
        pg8::gemm_phase<pg8::EpiProj, pg8::StaticOrder, true, true>((PG8_LAS unsigned char*)lds_raw, g, S, E);
    }
    SEAM(1);
    if (IN(2)) {
        float* lw = lds + wave * 2048;
        for (int item = gw; item < 512; item += ngw) p2_compress(a, lw, item, lane);
        for (int item = gw; item < 3 * NTOK * 8; item += ngw) p2_dilated(a, lw, item, lane);
    }
    SEAM(2);
    if (IN(3)) {
        float* lw = lds + wave * 1024;
        for (int tok = gw; tok < NTOK; tok += ngw) p3_combine(a, tok, lane);
        __syncthreads();
        {
            const int G_ = (int)gridDim.x, bx = (int)blockIdx.x, vcu = (G_ % 8 == 0) ? (bx % 8) * (G_ / 8) + bx / 8 : bx;
            for (int u = vcu; u < 256; u += G_) {
                const int bg = u >> 6, s_ = u & 63;
                mxa::unit(a, lds_raw, bg >> 1, bg & 1, s_);
                mxa::unit(a, lds_raw, bg >> 1, bg & 1, 127 - s_);
            }
        }
    }
    SEAM(3);
    if (IN(4)) p4_naive(a, lds);
#undef IN
#undef SEAM
}

extern "C" void kernel_launch(void* const* d_in, const int* in_sizes, int n_in, void* d_out, int out_size, void* d_ws, size_t ws_size, hipStream_t stream) {
    static int grid_blocks = 0;
    if (!grid_blocks) {
        int dev = 0, cus = 0, per_cu = 0;
        (void)hipGetDevice(&dev);
        (void)hipDeviceGetAttribute(&cus, hipDeviceAttributeMultiprocessorCount, dev);
        (void)hipFuncSetAttribute((const void*)mk_fwd, hipFuncAttributeMaxDynamicSharedMemorySize, LDS_BYTES);
        (void)hipOccupancyMaxActiveBlocksPerMultiprocessor(&per_cu, mk_fwd, NTHR, LDS_BYTES);
        if (per_cu < 1) { fprintf(stderr, "kernel_launch: occupancy query says %d blocks per CU\n", per_cu); per_cu = 1; }
        grid_blocks = cus;
        if (ws_size < WS_END) fprintf(stderr, "kernel_launch: workspace too small (%zu)\n", ws_size);
    }
    Args a{};
    a.x = (const float*)d_in[0]; a.pos = (const int*)d_in[1]; a.pre_g = (const float*)d_in[2]; a.w_in = (const float*)d_in[3];
    a.ck_pos = (const float*)d_in[4]; a.ck_w1 = (const float*)d_in[5]; a.ck_w2 = (const float*)d_in[6];
    a.cv_pos = (const float*)d_in[7]; a.cv_w1 = (const float*)d_in[8]; a.cv_w2 = (const float*)d_in[9];
    a.w_out = (const float*)d_in[10]; a.post_g = (const float*)d_in[11];
    a.out = (float*)d_out; a.ws = (unsigned char*)d_ws; a.ph_lo = 0; a.ph_hi = 5;
    void* args[] = {&a};
    hipError_t e = hipLaunchCooperativeKernel((void*)mk_fwd, dim3(grid_blocks), dim3(NTHR), args, LDS_BYTES, stream);
    if (e != hipSuccess) fprintf(stderr, "cooperative launch failed: %s (grid %d)\n", hipGetErrorString(e), grid_blocks);
}
```

```cpp
#include <hip/hip_runtime.h>
#include <hip/hip_cooperative_groups.h>
#include <cstdio>
#include <cstdint>
namespace cg = cooperative_groups;

constexpr int NB = 2, SEQ = 8192, DM = 1024, NTOK = NB * SEQ;
constexpr int NP = 4096;
constexpr int D_IN = 3864;
constexpr int C_QA = 0, C_KCMP = 512, C_VCMP = 640, C_KSLC = 768, C_VSLC = 896, C_KWIN = 1024, C_VWIN = 1152,
              C_GATE = 1280, C_ZA = 1536, C_QB = 2048, C_KB = 2560, C_VB = 3072, C_ZB = 3584;
constexpr float C2 = 0.18033688011112042f;
constexpr float RMS_EPS = 1e-6f;
constexpr int NTHR = 512, NWAVE = 8;

constexpr size_t MiB = 1u << 20;
constexpr size_t WS_WTIN = 2 * MiB;
constexpr size_t WS_WTOUT = 10 * MiB;
constexpr size_t WS_W1T = 12 * MiB;
constexpr size_t WS_W2T = 14 * MiB;
constexpr size_t WS_CMPB = 14 * MiB + 256 * 1024;
constexpr size_t WS_ROPE = 15 * MiB;
constexpr size_t WS_GATE = 16 * MiB;
constexpr size_t WS_KC = 18 * MiB;
constexpr size_t WS_VC = 18 * MiB + 512 * 1024;
constexpr size_t WS_LSEB = 19 * MiB;
constexpr size_t WS_H = 32 * MiB;
constexpr size_t WS_PROJ = 64 * MiB;
constexpr size_t WS_OB = 192 * MiB;
constexpr size_t WS_END = 240 * MiB;

typedef unsigned short bf16;
typedef unsigned int u32;

struct Args {
    const float* x; const int* pos; const float* pre_g; const float* w_in;
    const float* ck_pos; const float* ck_w1; const float* ck_w2;
    const float* cv_pos; const float* cv_w1; const float* cv_w2;
    const float* w_out; const float* post_g;
    float* out; unsigned char* ws;
    int ph_lo, ph_hi;
};

__device__ __forceinline__ u32 f2bf(float f) { u32 u = __builtin_bit_cast(u32, f); return (u + 0x7fffu + ((u >> 16) & 1u)) >> 16; }
__device__ __forceinline__ float bf2f(u32 b) { return __builtin_bit_cast(float, b << 16); }
__device__ __forceinline__ u32 pk2(float lo, float hi) { return f2bf(lo) | (f2bf(hi) << 16); }
__device__ __forceinline__ float bflo(u32 w) { return __builtin_bit_cast(float, w << 16); }
__device__ __forceinline__ float bfhi(u32 w) { return __builtin_bit_cast(float, w & 0xffff0000u); }
__device__ __forceinline__ float wave_sum(float v) {
#pragma unroll
    for (int o = 1; o < 64; o <<= 1) v += __shfl_xor(v, o);
    return v;
}
__device__ __forceinline__ float wave_max(float v) {
#pragma unroll
    for (int o = 1; o < 64; o <<= 1) v = fmaxf(v, __shfl_xor(v, o));
    return v;
}
__device__ __forceinline__ float silu_f(float v) { return v / (1.f + __expf(-v)); }
__device__ __forceinline__ float sigmoid_f(float v) { return 1.f / (1.f + __expf(-v)); }

namespace pg8 {
#define PG8_LAS __attribute__((address_space(3)))
typedef unsigned short bf16_t;
typedef short bf16x8 __attribute__((ext_vector_type(8)));
typedef float f32x4 __attribute__((ext_vector_type(4)));
typedef unsigned u32x4 __attribute__((ext_vector_type(4)));
constexpr int BM = 256, BK = 64, HALF = 128, HTB = HALF * BK * 2  , STAGE_BYTES = 8 * HTB, NXCD = 8, WGM = 8;

__host__ __device__ __forceinline__ int lds_byte(int r, int c) { const int st = (r >> 4) * 2 + (c >> 5), rr = r & 15, cc = c & 31, ob = rr * 64 + cc * 2; return st * 1024 + (ob ^ (((ob >> 9) & 1) << 5)); }
__host__ __device__ __forceinline__ void stage_rc(int b, int& R, int& C) { const int st = b / 1024, sb = b % 1024, swz = sb ^ (((sb >> 9) & 1) << 5); R = (st >> 1) * 16 + swz / 64; C = (st & 1) * 32 + (swz % 64) / 2; }
__host__ __device__ __forceinline__ int perm32(int rho) { const int n = rho >> 4, i = rho & 15; return 8 * (i >> 2) + 4 * n + (i & 3); }

struct Unit { int pm, pn; };
struct Gemm { const bf16_t* A; const bf16_t* Bt; int M, N, K; };

struct StaticOrder {
    int nM, nN, nwg, G, c;
    __host__ __device__ void init(int M, int N, int G_, int c_) { nM = M / BM; nN = N / BM; nwg = nM * nN; G = G_; c = c_; }
    __host__ __device__ bool next(int i, Unit& u) const {
        const long L = (long)i * G + c; if (L >= nwg) return false;
        int wgid = (int)L; { const int q = nwg / NXCD, r = nwg % NXCD, xcd = wgid % NXCD, off = wgid / NXCD; wgid = (xcd < r ? xcd * (q + 1) : r * (q + 1) + (xcd - r) * q) + off; }
        const int nig = WGM * nN, gid = wgid / nig, fm = gid * WGM, gsz = (nM - fm) < WGM ? (nM - fm) : WGM;
        u.pm = fm + ((wgid % nig) % gsz); u.pn = (wgid % nig) / gsz; return true;
    }
    __device__ __forceinline__ void a_ready(const Unit&) const {}
    __device__ __forceinline__ void done(const Unit&) const {}
};

__device__ __forceinline__ unsigned cvt_pk_bf16(float lo, float hi) { unsigned r; asm volatile("v_cvt_pk_bf16_f32 %0, %1, %2" : "=v"(r) : "v"(lo), "v"(hi)); return r; }

struct EpiProj {
    static constexpr bool PERM = true, AFTER_DRAIN = false;
    bf16_t* P; float* G; const float* RT; float qscale;
    __device__ __forceinline__ void operator()(const f32x4 (&acc)[2][2][4][2], const Unit& u, int wr, int wc, int fr, int fq) const {
        const int pn = u.pn;
        const int row0 = u.pm * BM + wr * 64 + fr;
        const int col0 = pn * BM + wc * 32 + 8 * fq;
        if (pn == 5) {
            if (wc == 0 && fq < 3) {
#pragma unroll
                for (int ai = 0; ai < 2; ++ai)
#pragma unroll
                    for (int m = 0; m < 4; ++m) {
                        float* gp = G + (size_t)(row0 + ai * HALF + m * 16) * 24 + 8 * fq;
                        f32x4 v0 = acc[ai][0][m][0], v1 = acc[ai][0][m][1];
#pragma unroll
                        for (int i = 0; i < 4; ++i) { v0[i] = 1.f / (1.f + __expf(-v0[i])); v1[i] = 1.f / (1.f + __expf(-v1[i])); }
                        *(f32x4*)gp = v0; *(f32x4*)(gp + 4) = v1;
                    }
            }
            return;
        }
        const bool rope0 = (pn <= 4) || (pn >= 8 && pn <= 11);
        const bool rope1 = (pn <= 1) || (pn >= 8 && pn <= 11);
        const bool isq = (pn <= 1) || pn == 8 || pn == 9;
        const bool isz = pn == 6 || pn == 7 || pn >= 14;
        const bool ropeW = ((wc & 1) == 0) && (rope0 || rope1);
        const float sc = isq ? qscale : 1.f;
#pragma unroll
        for (int ai = 0; ai < 2; ++ai)
#pragma unroll
            for (int m = 0; m < 4; ++m) {
                const int row = row0 + ai * HALF + m * 16;
                f32x4 c0 = {1.f, 1.f, 1.f, 1.f}, c1 = c0, s0 = {0.f, 0.f, 0.f, 0.f}, s1 = s0;
                if (ropeW) { const f32x4* rt = (const f32x4*)(RT + (size_t)row * 16); c0 = rt[0]; c1 = rt[1]; s0 = rt[2]; s1 = rt[3]; }
                bf16_t* rowp = P + (size_t)row * 4096 + col0;
#pragma unroll
                for (int bj = 0; bj < 2; ++bj) {
                    f32x4 v0 = acc[ai][bj][m][0], v1 = acc[ai][bj][m][1];
                    if (ropeW && (bj ? rope1 : rope0)) {
                        f32x4 o0, o1;
#pragma unroll
                        for (int i = 0; i < 4; ++i) { o0[i] = __shfl_xor(v0[i], 16); o1[i] = __shfl_xor(v1[i], 16); }
                        if (fq == 0) { v0 = v0 * c0 - o0 * s0; v1 = v1 * c1 - o1 * s1; }
                        else if (fq == 1) { v0 = v0 * c0 + o0 * s0; v1 = v1 * c1 + o1 * s1; }
                    }
                    if (isz) {
#pragma unroll
                        for (int i = 0; i < 4; ++i) { v0[i] = v0[i] / (1.f + __expf(-v0[i])); v1[i] = v1[i] / (1.f + __expf(-v1[i])); }
                    }
                    v0 = v0 * sc; v1 = v1 * sc;
                    u32x4 w; w.x = cvt_pk_bf16(v0[0], v0[1]); w.y = cvt_pk_bf16(v0[2], v0[3]); w.z = cvt_pk_bf16(v1[0], v1[1]); w.w = cvt_pk_bf16(v1[2], v1[3]);
                    *(u32x4*)(rowp + bj * HALF) = w;
                }
            }
    }
};
template <class Epi, class Sched, bool ALIGN_EPI = false, bool SP2 = false>
__device__ __forceinline__ void gemm_phase(PG8_LAS unsigned char* lds, const Gemm g, const Sched& S, const Epi& E) {
    const int tid = threadIdx.x, wid = __builtin_amdgcn_readfirstlane(tid >> 6), lane = tid & 63, wr = wid >> 2, wc = wid & 3, fr = lane & 15, fq = lane >> 4;
    const int K = g.K, nt = K / BK;
    unsigned voffA[2], voffB[2];
#pragma unroll
    for (int i = 0; i < 2; ++i) { int R, C; stage_rc(tid * 16 + i * 8192, R, C); const int Rb = Epi::PERM ? ((R & ~31) + perm32(R & 31)) : R;
        voffA[i] = (unsigned)(R * K + C) * 2u; voffB[i] = (unsigned)(Rb * K + C) * 2u; }
    const size_t kstep = (size_t)(BK * 2);
    const size_t hstep = (size_t)HALF * K * 2;
    const size_t tstep = 2 * hstep;
    const unsigned ldsw = (unsigned)wid * 1024u;
    const int aoff = lds_byte(wr * 64 + fr, fq * 8), boff = lds_byte(wc * 32 + fr, fq * 8);
#define PG8_SA(b, h) (((b) * 2 + (h)) * HTB)
#define PG8_SB(b, h) ((4 + (b) * 2 + (h)) * HTB)
#define PG8_STAGE(bufoff, gbase, voff) do { _Pragma("unroll") for (int _i = 0; _i < 2; ++_i) \
        __builtin_amdgcn_global_load_lds((const unsigned*)((const char*)(gbase) + (voff)[_i]), (PG8_LAS unsigned*)(lds + (bufoff) + ldsw + _i * 8192), 16, 0, 0); } while (0)
#define PG8_LDA(dst, b, h) do { _Pragma("unroll") for (int m = 0; m < 4; ++m) _Pragma("unroll") for (int k = 0; k < 2; ++k) dst[m][k] = *(const PG8_LAS bf16x8*)(lds + PG8_SA(b, h) + aoff + m * 2048 + k * 1024); } while (0)
#define PG8_LDB(dst, b, h) do { _Pragma("unroll") for (int n = 0; n < 2; ++n) _Pragma("unroll") for (int k = 0; k < 2; ++k) dst[n][k] = *(const PG8_LAS bf16x8*)(lds + PG8_SB(b, h) + boff + n * 2048 + k * 1024); } while (0)
#define PG8_MMA(ai, bj, At, Bt) do { __builtin_amdgcn_s_setprio(1); _Pragma("unroll") for (int m = 0; m < 4; ++m) _Pragma("unroll") for (int n = 0; n < 2; ++n) _Pragma("unroll") for (int k = 0; k < 2; ++k) \
        acc[ai][bj][m][n] = __builtin_amdgcn_mfma_f32_16x16x32_bf16(Bt[n][k], At[m][k], acc[ai][bj][m][n], 0, 0, 0); __builtin_amdgcn_s_setprio(0); } while (0)
#define PG8_WAIT_V(n) asm volatile("s_waitcnt vmcnt(" #n ")" ::: "memory")
#define PG8_WAIT_L(n) asm volatile("s_waitcnt lgkmcnt(" #n ")" ::: "memory")
#define PG8_BAR __builtin_amdgcn_s_barrier()
#define PG8_SCHED __builtin_amdgcn_sched_barrier(0)
    Unit cur, nxt; int ui = 0;
    if (!S.next(0, cur)) return;
    f32x4 acc[2][2][4][2];
#pragma unroll
    for (int a = 0; a < 2; ++a)
#pragma unroll
        for (int b = 0; b < 2; ++b)
#pragma unroll
            for (int m = 0; m < 4; ++m)
#pragma unroll
                for (int n = 0; n < 2; ++n) acc[a][b][m][n] = (f32x4){0.f, 0.f, 0.f, 0.f};
    bf16x8 At[4][2], B0[2][2], B1[2][2];
    const char* cA = (const char*)g.A + (size_t)cur.pm * tstep; const char* cB = (const char*)g.Bt + (size_t)cur.pn * tstep;
    S.a_ready(cur);
    if constexpr (SP2) {
        PG8_STAGE(PG8_SB(0, 0), cB, voffB); PG8_STAGE(PG8_SB(0, 1), cB + hstep, voffB); PG8_STAGE(PG8_SA(0, 0), cA, voffA); PG8_STAGE(PG8_SA(0, 1), cA + hstep, voffA);
        if (wr == 1) PG8_BAR;
        PG8_WAIT_V(2); PG8_BAR;
        PG8_STAGE(PG8_SB(1, 0), cB + kstep, voffB); PG8_STAGE(PG8_SA(1, 0), cA + kstep, voffA); PG8_STAGE(PG8_SB(1, 1), cB + hstep + kstep, voffB);
        PG8_WAIT_V(6); PG8_BAR;
    } else {
        PG8_STAGE(PG8_SB(0, 0), cB, voffB); PG8_STAGE(PG8_SA(0, 0), cA, voffA); PG8_STAGE(PG8_SB(0, 1), cB + hstep, voffB); PG8_STAGE(PG8_SA(0, 1), cA + hstep, voffA);
        if (wr == 1) PG8_BAR;
        PG8_WAIT_V(4); PG8_BAR;
        PG8_STAGE(PG8_SB(1, 0), cB + kstep, voffB); PG8_STAGE(PG8_SA(1, 0), cA + kstep, voffA); PG8_STAGE(PG8_SB(1, 1), cB + hstep + kstep, voffB);
        PG8_WAIT_V(6); PG8_BAR;
    }
    for (;;) {
        const bool has_next = S.next(ui + 1, nxt);
        const char* nA = has_next ? (const char*)g.A + (size_t)nxt.pm * tstep : cA; const char* nB = has_next ? (const char*)g.Bt + (size_t)nxt.pn * tstep : cB;
        for (int t = 0; t < nt; t += 2) {
            const bool last = (t == nt - 2);
            const char* a1 = cA + (size_t)(t + 1) * kstep;
            const char* a2 = last ? nA : cA + (size_t)(t + 2) * kstep; const char* b2 = last ? nB : cB + (size_t)(t + 2) * kstep;
            const char* a3 = a2 + kstep; const char* b3 = b2 + kstep;
            if (last && has_next) S.a_ready(nxt);
            if constexpr (SP2) {
            PG8_LDB(B0, 0, 0); PG8_LDB(B1, 0, 1); PG8_SCHED; PG8_LDA(At, 0, 0); PG8_STAGE(PG8_SA(1, 1), a1 + hstep, voffA);
            PG8_WAIT_V(8); PG8_WAIT_L(0); PG8_BAR; PG8_MMA(0, 0, At, B0); PG8_MMA(0, 1, At, B1); PG8_BAR; PG8_SCHED;
            PG8_LDA(At, 0, 1); PG8_STAGE(PG8_SB(0, 0), b2, voffB); PG8_STAGE(PG8_SB(0, 1), b2 + hstep, voffB); PG8_STAGE(PG8_SA(0, 0), a2, voffA);
            PG8_WAIT_V(8); PG8_WAIT_L(0); PG8_BAR; PG8_MMA(1, 0, At, B0); PG8_MMA(1, 1, At, B1); PG8_BAR; PG8_SCHED;
            PG8_LDB(B0, 1, 0); PG8_LDB(B1, 1, 1); PG8_SCHED; PG8_LDA(At, 1, 0); PG8_STAGE(PG8_SA(0, 1), a2 + hstep, voffA);
            PG8_WAIT_V(8); PG8_WAIT_L(0); PG8_BAR; PG8_MMA(0, 0, At, B0); PG8_MMA(0, 1, At, B1); PG8_BAR; PG8_SCHED;
            PG8_LDA(At, 1, 1); PG8_STAGE(PG8_SB(1, 0), b3, voffB); PG8_STAGE(PG8_SB(1, 1), b3 + hstep, voffB); PG8_STAGE(PG8_SA(1, 0), a3, voffA);
            PG8_WAIT_V(8); PG8_WAIT_L(0); PG8_BAR; PG8_MMA(1, 0, At, B0); PG8_MMA(1, 1, At, B1); PG8_BAR; PG8_SCHED;
            } else {
            PG8_LDB(B0, 0, 0); PG8_SCHED; PG8_LDA(At, 0, 0); PG8_STAGE(PG8_SA(1, 1), a1 + hstep, voffA);
            PG8_WAIT_L(8); PG8_BAR; PG8_WAIT_L(0); PG8_MMA(0, 0, At, B0); PG8_BAR; PG8_SCHED;
            PG8_LDB(B1, 0, 1); PG8_STAGE(PG8_SB(0, 0), b2, voffB);
            PG8_BAR; PG8_WAIT_L(0); PG8_MMA(0, 1, At, B1); PG8_BAR;
            PG8_LDA(At, 0, 1); PG8_STAGE(PG8_SA(0, 0), a2, voffA);
            PG8_BAR; PG8_WAIT_L(0); PG8_MMA(1, 0, At, B0); PG8_BAR; PG8_SCHED;
            PG8_STAGE(PG8_SB(0, 1), b2 + hstep, voffB);
            PG8_WAIT_V(6); PG8_BAR; PG8_MMA(1, 1, At, B1); PG8_BAR;
            PG8_LDB(B0, 1, 0); PG8_SCHED; PG8_LDA(At, 1, 0); PG8_STAGE(PG8_SA(0, 1), a2 + hstep, voffA);
            PG8_WAIT_L(8); PG8_BAR; PG8_WAIT_L(0); PG8_MMA(0, 0, At, B0); PG8_BAR; PG8_SCHED;
            PG8_LDB(B1, 1, 1); PG8_STAGE(PG8_SB(1, 0), b3, voffB);
            PG8_BAR; PG8_WAIT_L(0); PG8_MMA(0, 1, At, B1); PG8_BAR;
            PG8_LDA(At, 1, 1); PG8_STAGE(PG8_SA(1, 0), a3, voffA);
            PG8_BAR; PG8_WAIT_L(0); PG8_MMA(1, 0, At, B0); PG8_BAR; PG8_SCHED;
            PG8_STAGE(PG8_SB(1, 1), b3 + hstep, voffB);
            PG8_WAIT_V(6); PG8_BAR; PG8_MMA(1, 1, At, B1); PG8_BAR;
            }
        }
        if constexpr (ALIGN_EPI) { if (wr == 0) PG8_BAR; }
        if constexpr (!Epi::AFTER_DRAIN) { E(acc, cur, wr, wc, fr, fq); S.done(cur); }
        if (!has_next) break;
#pragma unroll
        for (int a = 0; a < 2; ++a)
#pragma unroll
            for (int b = 0; b < 2; ++b)
#pragma unroll
                for (int m = 0; m < 4; ++m)
#pragma unroll
                    for (int n = 0; n < 2; ++n) acc[a][b][m][n] = (f32x4){0.f, 0.f, 0.f, 0.f};
        cur = nxt; cA = nA; cB = nB; ++ui;
        if constexpr (ALIGN_EPI) { if (wr == 1) PG8_BAR; }
    }
    PG8_WAIT_V(0);
    if constexpr (!ALIGN_EPI) { if (wr == 0) PG8_BAR; }
    PG8_BAR;
    if constexpr (Epi::AFTER_DRAIN) { E.fused(acc, cur, wr, wc, fr, fq, lds, wid, lane); S.done(cur); }
#undef PG8_SA
#undef PG8_SB
#undef PG8_STAGE
#undef PG8_LDA
#undef PG8_LDB
#undef PG8_MMA
#undef PG8_WAIT_V
#undef PG8_WAIT_L
#undef PG8_BAR
#undef PG8_SCHED
}
}

__device__ __forceinline__ int wcol_of_n(int n) {
    if (n < 1304) return n;
    if (n < 1536) return -1;
    return n - 232;
}
__device__ void p0_prologue(const Args& a, float* lds) {
    const int tid = threadIdx.x, lane = tid & 63, wave = __builtin_amdgcn_readfirstlane(tid >> 6);
    const int gw = blockIdx.x * NWAVE + wave, ngw = gridDim.x * NWAVE;
    const int gt = blockIdx.x * NTHR + tid, ngt = gridDim.x * NTHR;
    bf16* H = (bf16*)(a.ws + WS_H);
    for (int row = gw; row < NTOK; row += ngw) {
        const float4* xr = (const float4*)(a.x + (size_t)row * DM) + lane;
        const float4* gr = (const float4*)a.pre_g + lane;
        float4 v[4]; float s = 0.f;
#pragma unroll
        for (int j = 0; j < 4; ++j) { v[j] = xr[64 * j]; s += v[j].x * v[j].x + v[j].y * v[j].y + v[j].z * v[j].z + v[j].w * v[j].w; }
        s = wave_sum(s);
        const float rinv = rsqrtf(s * (1.f / DM) + RMS_EPS);
        uint2* o = (uint2*)(H + (size_t)row * DM) + lane;
#pragma unroll
        for (int j = 0; j < 4; ++j) { const float4 g = gr[64 * j];
            uint2 w; w.x = pk2(v[j].x * rinv * g.x, v[j].y * rinv * g.y); w.y = pk2(v[j].z * rinv * g.z, v[j].w * rinv * g.w); o[64 * j] = w; }
    }
    bf16* WT = (bf16*)(a.ws + WS_WTIN);
    for (int it = gt; it < NP * (DM / 8); it += ngt) {
        const int n = it % NP, kc = it / NP, k0 = kc * 8;
        const int c = wcol_of_n(n);
        float f[8];
#pragma unroll
        for (int i = 0; i < 8; ++i) f[i] = (c >= 0) ? a.w_in[(size_t)(k0 + i) * D_IN + c] : 0.f;
        uint4 w; w.x = pk2(f[0], f[1]); w.y = pk2(f[2], f[3]); w.z = pk2(f[4], f[5]); w.w = pk2(f[6], f[7]);
        *(uint4*)(WT + (size_t)n * DM + k0) = w;
    }
    {
        auto tr = [&](const float* W, int K, int N, bf16* WTo) {
            for (int it = gt; it < N * (K / 8); it += ngt) {
                const int n = it % N, k0 = (it / N) * 8;
                float f[8];
#pragma unroll
                for (int i = 0; i < 8; ++i) f[i] = W[(size_t)(k0 + i) * N + n];
                uint4 w; w.x = pk2(f[0], f[1]); w.y = pk2(f[2], f[3]); w.z = pk2(f[4], f[5]); w.w = pk2(f[6], f[7]);
                *(uint4*)(WTo + (size_t)n * K + k0) = w;
            }
        };
        tr(a.w_out, DM, DM, (bf16*)(a.ws + WS_WTOUT));
        tr(a.ck_w1, 2048, 256, (bf16*)(a.ws + WS_W1T));
        tr(a.cv_w1, 2048, 256, (bf16*)(a.ws + WS_W1T) + 256 * 2048);
        tr(a.ck_w2, 256, 64, (bf16*)(a.ws + WS_W2T));
        tr(a.cv_w2, 256, 64, (bf16*)(a.ws + WS_W2T) + 64 * 256);
    }
    float* RT = (float*)(a.ws + WS_ROPE);
    for (int it = gt; it < NTOK * 8; it += ngt) {
        const int tok = it >> 3, i = it & 7;
        const float inv[8] = {1.0f, 0.193922758102417f, 0.03760603070259094f, 0.00729266507551074f, 0.001414213445968926f,
                              0.00027424818836152554f, 5.318296462064609e-05f, 1.0313385246263351e-05f};
        float iv = inv[0];
#pragma unroll
        for (int q = 1; q < 8; ++q) iv = (i == q) ? inv[q] : iv;
        const float ang = (float)a.pos[tok] * iv;
        RT[tok * 16 + i] = cosf(ang); RT[tok * 16 + 8 + i] = sinf(ang);
    }
    if (blockIdx.x < 16) {
        const int m = blockIdx.x >> 3, n0 = (blockIdx.x & 7) * 32, nn = tid & 31, ks = tid >> 5;
        const float* pe = m ? a.cv_pos : a.ck_pos; const float* w1 = m ? a.cv_w1 : a.ck_w1;
        float acc = 0.f;
        for (int k = ks * 128; k < ks * 128 + 128; ++k) acc += pe[k] * w1[(size_t)k * 256 + n0 + nn];
        lds[ks * 32 + nn] = acc;
        __syncthreads();
        if (tid < 32) { float s = 0.f; for (int q = 0; q < 16; ++q) s += lds[q * 32 + tid]; ((float*)(a.ws + WS_CMPB))[m * 256 + n0 + tid] = s; }
        __syncthreads();
    }
}

__device__ __forceinline__ void epi16(const Args& a, int row, int n16, float (&v)[16]) {
    if (n16 >= C_GATE && n16 < C_ZA) {
        if (n16 >= 1304) return;
        float* G = (float*)(a.ws + WS_GATE) + (size_t)row * 24;
#pragma unroll
        for (int i = 0; i < 16; ++i) { const int gi = n16 - C_GATE + i; if (gi < 24) G[gi] = sigmoid_f(v[i]); }
        return;
    }
    const bool isq = (n16 < C_KCMP) || (n16 >= C_QB && n16 < C_KB);
    const bool isz = (n16 >= C_ZA && n16 < C_QB) || (n16 >= C_ZB);
    const bool isk = (n16 >= C_KCMP && n16 < C_VCMP) || (n16 >= C_KSLC && n16 < C_VSLC) || (n16 >= C_KWIN && n16 < C_VWIN) || (n16 >= C_KB && n16 < C_VB);
    if ((isq || isk) && (n16 & 63) == 0) {
        const float* rt = (const float*)(a.ws + WS_ROPE) + (size_t)row * 16;
#pragma unroll
        for (int i = 0; i < 8; ++i) { const float c = rt[i], s = rt[8 + i], x1 = v[i], x2 = v[8 + i]; v[i] = x1 * c - x2 * s; v[8 + i] = x2 * c + x1 * s; }
    }
    if (isq) {
#pragma unroll
        for (int i = 0; i < 16; ++i) v[i] *= C2;
    }
    if (isz) {
#pragma unroll
        for (int i = 0; i < 16; ++i) v[i] = silu_f(v[i]);
    }
    bf16* P = (bf16*)(a.ws + WS_PROJ) + (size_t)row * NP + n16;
    uint4 w0, w1;
    w0.x = pk2(v[0], v[1]); w0.y = pk2(v[2], v[3]); w0.z = pk2(v[4], v[5]); w0.w = pk2(v[6], v[7]);
    w1.x = pk2(v[8], v[9]); w1.y = pk2(v[10], v[11]); w1.z = pk2(v[12], v[13]); w1.w = pk2(v[14], v[15]);
    ((uint4*)P)[0] = w0; ((uint4*)P)[1] = w1;
}
__device__ void p1_naive(const Args& a, float* lds) {
    const int tid = threadIdx.x, tx = tid & 15, ty = tid >> 4;
    float* As = lds;
    float* Bs = lds + 32 * 64;
    const bf16* H = (const bf16*)(a.ws + WS_H); const bf16* WT = (const bf16*)(a.ws + WS_WTIN);
    for (int tile = blockIdx.x; tile < (NTOK / 64) * (NP / 256); tile += gridDim.x) {
        const int pm = tile / (NP / 256), pn = tile % (NP / 256);
        const int row0 = pm * 64, n0 = pn * 256;
        float acc[2][16];
#pragma unroll
        for (int r = 0; r < 2; ++r)
#pragma unroll
            for (int c = 0; c < 16; ++c) acc[r][c] = 0.f;
        for (int k0 = 0; k0 < DM; k0 += 32) {
            { const int r = tid >> 3, kq = (tid & 7) * 4;
              const uint2 w = *(const uint2*)(H + (size_t)(row0 + r) * DM + k0 + kq);
              As[(kq + 0) * 64 + r] = bflo(w.x); As[(kq + 1) * 64 + r] = bfhi(w.x); As[(kq + 2) * 64 + r] = bflo(w.y); As[(kq + 3) * 64 + r] = bfhi(w.y); }
            { const int n = tid >> 1, kh = (tid & 1) * 16;
              const uint4 w0 = *(const uint4*)(WT + (size_t)(n0 + n) * DM + k0 + kh);
              const uint4 w1 = *(const uint4*)(WT + (size_t)(n0 + n) * DM + k0 + kh + 8);
              float* b = Bs + kh * 256 + n;
              b[0 * 256] = bflo(w0.x); b[1 * 256] = bfhi(w0.x); b[2 * 256] = bflo(w0.y); b[3 * 256] = bfhi(w0.y);
              b[4 * 256] = bflo(w0.z); b[5 * 256] = bfhi(w0.z); b[6 * 256] = bflo(w0.w); b[7 * 256] = bfhi(w0.w);
              b[8 * 256] = bflo(w1.x); b[9 * 256] = bfhi(w1.x); b[10 * 256] = bflo(w1.y); b[11 * 256] = bfhi(w1.y);
              b[12 * 256] = bflo(w1.z); b[13 * 256] = bfhi(w1.z); b[14 * 256] = bflo(w1.w); b[15 * 256] = bfhi(w1.w); }
            __syncthreads();
#pragma unroll 4
            for (int k = 0; k < 32; ++k) {
                const float a0 = As[k * 64 + 2 * ty], a1 = As[k * 64 + 2 * ty + 1];
                const float4* bp = (const float4*)(Bs + k * 256 + 16 * tx);
                const float4 b0 = bp[0], b1 = bp[1], b2 = bp[2], b3 = bp[3];
                const float bb[16] = {b0.x, b0.y, b0.z, b0.w, b1.x, b1.y, b1.z, b1.w, b2.x, b2.y, b2.z, b2.w, b3.x, b3.y, b3.z, b3.w};
#pragma unroll
                for (int c = 0; c < 16; ++c) { acc[0][c] += a0 * bb[c]; acc[1][c] += a1 * bb[c]; }
            }
            __syncthreads();
        }
        epi16(a, row0 + 2 * ty, n0 + 16 * tx, acc[0]);
        epi16(a, row0 + 2 * ty + 1, n0 + 16 * tx, acc[1]);
    }
}

template <int R> struct WAttn {
    float m[R], l[R], o[R];
    __device__ __forceinline__ void init() {
#pragma unroll
        for (int r = 0; r < R; ++r) { m[r] = -INFINITY; l[r] = 0.f; o[r] = 0.f; }
    }
    __device__ __forceinline__ void scores(const float* qs, const bf16* krow, float (&s)[R]) {
#pragma unroll
        for (int r = 0; r < R; ++r) s[r] = 0.f;
        uint4 kc = ((const uint4*)krow)[0];
#pragma unroll 1
        for (int i = 0; i < 8; ++i) {
            const uint4 kn = ((const uint4*)krow)[i < 7 ? i + 1 : 7];
            const float k0 = bflo(kc.x), k1 = bfhi(kc.x), k2 = bflo(kc.y), k3 = bfhi(kc.y), k4 = bflo(kc.z), k5 = bfhi(kc.z), k6 = bflo(kc.w), k7 = bfhi(kc.w);
#pragma unroll
            for (int r = 0; r < R; ++r) {
                const float4 q0 = *(const float4*)(qs + r * 64 + i * 8), q1 = *(const float4*)(qs + r * 64 + i * 8 + 4);
                s[r] += q0.x * k0 + q0.y * k1 + q0.z * k2 + q0.w * k3 + q1.x * k4 + q1.y * k5 + q1.z * k6 + q1.w * k7;
            }
            kc = kn;
        }
    }
    __device__ __forceinline__ void chunk(const float* qs, const bf16* krow, const bf16* vrow, bool valid, int lane) {
        float s[R]; scores(qs, krow, s);
        float p[R];
#pragma unroll
        for (int r = 0; r < R; ++r) {
            const float sv = valid ? s[r] : -INFINITY;
            const float mx = wave_max(sv);
            const float mn = fmaxf(m[r], mx);
            float alpha = 1.f, pv = 0.f;
            if (mn > -INFINITY) { alpha = exp2f(m[r] - mn); pv = valid ? exp2f(sv - mn) : 0.f; }
            l[r] = l[r] * alpha + wave_sum(pv); o[r] *= alpha; m[r] = mn; p[r] = pv;
        }
        const unsigned long long vaddr = (unsigned long long)vrow;
#pragma unroll 4
        for (int key = 0; key < 64; ++key) {
            const unsigned long long va = __shfl(vaddr, key);
            const float vv = bf2f(((const bf16*)va)[lane]);
#pragma unroll
            for (int r = 0; r < R; ++r) o[r] += __shfl(p[r], key) * vv;
        }
    }
};

__device__ void p2_compress(const Args& a, float* lds_wave, int item, int lane) {
    const int prob = item >> 6, cg8 = item & 63, kv = prob & 1, bg = prob >> 1, b = bg >> 1, g = bg & 1;
    const int c0 = cg8 * 8;
    const float* w1 = kv ? a.cv_w1 : a.ck_w1; const float* w2 = kv ? a.cv_w2 : a.ck_w2;
    const float* bias = (const float*)(a.ws + WS_CMPB) + kv * 256;
    const bf16* src = (const bf16*)(a.ws + WS_PROJ) + (size_t)b * SEQ * NP + (kv ? C_VCMP : C_KCMP) + g * 64;
    float acc[8][4];
#pragma unroll
    for (int c = 0; c < 8; ++c)
#pragma unroll
        for (int i = 0; i < 4; ++i) acc[c][i] = 0.f;
    for (int k = 0; k < 2048; ++k) {
        const int tok_off = k >> 6, d = k & 63;
        float w[4];
#pragma unroll
        for (int i = 0; i < 4; ++i) w[i] = w1[(size_t)k * 256 + lane + 64 * i];
#pragma unroll
        for (int c = 0; c < 8; ++c) {
            int tok = 16 * (c0 + c) + tok_off; tok = tok < SEQ ? tok : SEQ - 1;
            const float av = bf2f(src[(size_t)tok * NP + d]);
#pragma unroll
            for (int i = 0; i < 4; ++i) acc[c][i] += av * w[i];
        }
    }
#pragma unroll
    for (int c = 0; c < 8; ++c)
#pragma unroll
        for (int i = 0; i < 4; ++i) lds_wave[c * 256 + lane + 64 * i] = silu_f(acc[c][i] + bias[lane + 64 * i]);
    __builtin_amdgcn_s_waitcnt(0xc07f);
    asm volatile("" ::: "memory");
    float out[8];
#pragma unroll
    for (int c = 0; c < 8; ++c) out[c] = 0.f;
    for (int n = 0; n < 256; ++n) {
        const float w = w2[n * 64 + lane];
#pragma unroll
        for (int c = 0; c < 8; ++c) out[c] += lds_wave[c * 256 + n] * w;
    }
    bf16* dst = (bf16*)(a.ws + (kv ? WS_VC : WS_KC)) + (size_t)bg * 512 * 64;
#pragma unroll
    for (int c = 0; c < 8; ++c) dst[(size_t)(c0 + c) * 64 + lane] = (bf16)((c0 + c) < 511 ? f2bf(out[c]) : 0u);
    asm volatile("" ::: "memory");
}
__device__ void p2_dilated(const Args& a, float* qs, int item, int lane) {
    const int h = item & 7, tok = (item >> 3) & (NTOK - 1), p = item >> 17;
    const int b = tok >> 13, t = tok & (SEQ - 1);
    const int dil = (p == 0) ? 1 : (p == 1) ? 4 : 16, sh = (p == 0) ? 0 : (p == 1) ? 2 : 4;
    const bf16* P = (const bf16*)(a.ws + WS_PROJ);
    qs[lane] = bf2f(P[(size_t)tok * NP + C_QB + h * 64 + lane]);
    __builtin_amdgcn_s_waitcnt(0xc07f); asm volatile("" ::: "memory");
    const int i = t >> sh, r = t & (dil - 1);
    WAttn<1> A; A.init();
    for (int c = 0; c < 3; ++c) {
        const int jd = i - 191 + 64 * c + lane;
        const bool valid = (jd >= 0) && (jd >= i - 128) && (jd <= i);
        const int jc = jd < 0 ? 0 : jd;
        const size_t krow = (size_t)(b * SEQ + jc * dil + r) * NP;
        A.chunk(qs, P + krow + C_KB + h * 64, P + krow + C_VB + h * 64, valid, lane);
    }
    bf16* OB = (bf16*)(a.ws + WS_OB) + (size_t)p * NTOK * 512;
    OB[(size_t)tok * 512 + h * 64 + lane] = (bf16)f2bf(A.o[0] / A.l[0]);
    if (lane == 0) ((float*)(a.ws + WS_LSEB))[((size_t)p * NTOK + tok) * 8 + h] = A.m[0] + log2f(A.l[0]);
    asm volatile("" ::: "memory");
}

__device__ void p3_combine(const Args& a, int tok, int lane) {
    const int h = lane >> 3;
    const float* L = (const float*)(a.ws + WS_LSEB);
    const float l0 = L[((size_t)0 * NTOK + tok) * 8 + h], l1 = L[((size_t)1 * NTOK + tok) * 8 + h], l2 = L[((size_t)2 * NTOK + tok) * 8 + h];
    const float mx = fmaxf(l0, fmaxf(l1, l2));
    float w0 = exp2f(l0 - mx), w1 = exp2f(l1 - mx), w2 = exp2f(l2 - mx);
    const float inv = 1.f / (w0 + w1 + w2); w0 *= inv; w1 *= inv; w2 *= inv;
    const bf16* OB = (const bf16*)(a.ws + WS_OB);
    const uint4 o0 = *(const uint4*)(OB + ((size_t)0 * NTOK + tok) * 512 + lane * 8);
    const uint4 o1 = *(const uint4*)(OB + ((size_t)1 * NTOK + tok) * 512 + lane * 8);
    const uint4 o2 = *(const uint4*)(OB + ((size_t)2 * NTOK + tok) * 512 + lane * 8);
    const uint4 z = *(const uint4*)((const bf16*)(a.ws + WS_PROJ) + (size_t)tok * NP + C_ZB + lane * 8);
    uint4 r;
#define CMB(f) r.f = pk2((w0 * bflo(o0.f) + w1 * bflo(o1.f) + w2 * bflo(o2.f)) * bflo(z.f), (w0 * bfhi(o0.f) + w1 * bfhi(o1.f) + w2 * bfhi(o2.f)) * bfhi(z.f))
    CMB(x); CMB(y); CMB(z); CMB(w);
#undef CMB
    *(uint4*)((bf16*)(a.ws + WS_H) + (size_t)tok * DM + 512 + lane * 8) = r;
}
__device__ void p3_mixer_a(const Args& a, float* qs, float* imp, int item, int lane) {
    const int g = item & 1, tok = item >> 1, b = tok >> 13, t = tok & (SEQ - 1);
    const bf16* P = (const bf16*)(a.ws + WS_PROJ);
    const bf16* Pb = P + (size_t)b * SEQ * NP;
#pragma unroll
    for (int r = 0; r < 4; ++r) qs[r * 64 + lane] = bf2f(P[(size_t)tok * NP + C_QA + (g * 4 + r) * 64 + lane]);
#pragma unroll
    for (int i = 0; i < 8; ++i) imp[lane + 64 * i] = 0.f;
    __builtin_amdgcn_s_waitcnt(0xc07f); asm volatile("" ::: "memory");
    const float* G = (const float*)(a.ws + WS_GATE) + (size_t)tok * 24;
    float tot[4] = {0.f, 0.f, 0.f, 0.f};
    const int cur = t >> 6;
    const bf16* KC = (const bf16*)(a.ws + WS_KC) + (size_t)(b * 2 + g) * 512 * 64;
    const bf16* VC = (const bf16*)(a.ws + WS_VC) + (size_t)(b * 2 + g) * 512 * 64;
    const int cmax = (t >= 31) ? ((t - 31) >> 4) : -1;
    const int swa_base = (t & ~63) - 512;
    unsigned long long m0 = 0ull, m1 = 0ull;
    WAttn<4> A;
#pragma unroll 1
    for (int br = 0; br < 3; ++br) {
        A.init();
        const int nch = (br == 0) ? ((cmax >= 0) ? (cmax >> 6) + 1 : 0) : (br == 1) ? cur + 1 : 9;
#pragma unroll 1
        for (int c = 0; c < nch; ++c) {
            const bf16 *kp, *vp; bool valid;
            if (br == 0) { const int cc = c * 64 + lane; kp = KC + (size_t)cc * 64; vp = VC + (size_t)cc * 64; valid = cc <= cmax; }
            else if (br == 1) {
                const bool sel = (c < 64) ? ((m0 >> c) & 1ull) : ((m1 >> (c - 64)) & 1ull);
                if (!sel) continue;
                const int key = c * 64 + lane; const size_t ro = (size_t)key * NP + g * 64;
                kp = Pb + ro + C_KSLC; vp = Pb + ro + C_VSLC; valid = key <= t;
            } else {
                if (swa_base + 64 * c + 63 < 0) continue;
                const int key = swa_base + 64 * c + lane;
                valid = key >= 0 && key <= t && (t - key) <= 511;
                const int kc2 = key < 0 ? 0 : key; const size_t ro = (size_t)kc2 * NP + g * 64;
                kp = Pb + ro + C_KWIN; vp = Pb + ro + C_VWIN;
            }
            A.chunk(qs, kp, vp, valid, lane);
        }
        float rl[4];
#pragma unroll
        for (int r = 0; r < 4; ++r) { rl[r] = (A.l[r] > 0.f) ? 1.f / A.l[r] : 0.f; tot[r] += G[br * 8 + g * 4 + r] * A.o[r] * rl[r]; }
        if (br == 0) {
#pragma unroll 1
            for (int c = 0; c < nch; ++c) {
                const int cc = c * 64 + lane; float s[4]; A.scores(qs, KC + (size_t)cc * 64, s);
                float ip = 0.f;
#pragma unroll
                for (int r = 0; r < 4; ++r) ip += (cc <= cmax) ? exp2f(s[r] - A.m[r]) * rl[r] : 0.f;
                imp[cc] = ip;
            }
            __builtin_amdgcn_s_waitcnt(0xc07f); asm volatile("" ::: "memory");
            float sc[2];
#pragma unroll
            for (int q = 0; q < 2; ++q) {
                const int j = lane + 64 * q;
                float v = (j > 0 ? imp[4 * j - 1] : 0.f) + 2.f * imp[4 * j] + 2.f * imp[4 * j + 1] + 2.f * imp[4 * j + 2] + imp[4 * j + 3];
                if (j == 0 || j == cur || j == cur - 1) v = 1e4f;
                if (j > cur) v = -1.f;
                sc[q] = v;
            }
#pragma unroll 1
            for (int it = 0; it < 16; ++it) {
                float bv; int bi;
                if (sc[0] >= sc[1]) { bv = sc[0]; bi = lane; } else { bv = sc[1]; bi = lane + 64; }
#pragma unroll
                for (int off = 32; off >= 1; off >>= 1) {
                    const float ov = __shfl_xor(bv, off); const int oi = __shfl_xor(bi, off);
                    if (ov > bv || (ov == bv && oi < bi)) { bv = ov; bi = oi; }
                }
                bi = __builtin_amdgcn_readfirstlane(bi);
                if (bi <= cur) { if (bi < 64) m0 |= 1ull << bi; else m1 |= 1ull << (bi - 64); }
                if (bi == lane) sc[0] = -2.f;
                if (bi == lane + 64) sc[1] = -2.f;
            }
        }
    }
    bf16* MX = (bf16*)(a.ws + WS_H) + (size_t)tok * DM;
#pragma unroll
    for (int r = 0; r < 4; ++r) { const int col = (g * 4 + r) * 64 + lane; MX[col] = (bf16)f2bf(tot[r] * bf2f(P[(size_t)tok * NP + C_ZA + col])); }
    asm volatile("" ::: "memory");
}


namespace mxa {
#define MXA_LAS __attribute__((address_space(3)))
typedef short bf16x8 __attribute__((ext_vector_type(8)));
typedef short s16x4 __attribute__((ext_vector_type(4)));
typedef float f32x16 __attribute__((ext_vector_type(16)));
typedef unsigned u32x4 __attribute__((ext_vector_type(4)));
typedef float f32x2_t __attribute__((ext_vector_type(2))); typedef __bf16 bf16x2_t __attribute__((ext_vector_type(2)));
typedef MXA_LAS const char* lds_cptr;
constexpr int SLOT = 16384;
constexpr int L_SC = 32768;
constexpr int L_MASK = 65536;
constexpr int L_WSF = 66560;
constexpr int L_TOT = 69632;
__device__ __forceinline__ int crow(int r, int hi) { return (r & 3) + 8 * (r >> 2) + 4 * hi; }
__device__ __forceinline__ unsigned cvtpk(float lo, float hi) { f32x2_t v = {lo, hi}; bf16x2_t b = __builtin_convertvector(v, bf16x2_t); return __builtin_bit_cast(unsigned, b); }
__device__ __forceinline__ s16x4 vtr(lds_cptr p) { typedef short v4i16_t __attribute__((ext_vector_type(4))); return __builtin_bit_cast(s16x4, __builtin_amdgcn_ds_read_tr16_b64_v4i16((MXA_LAS v4i16_t*)p)); }
__device__ __forceinline__ float ex2(float v) { return __builtin_amdgcn_exp2f(v); }

__device__ __forceinline__ void qkt(f32x16& p0, f32x16& p1, lds_cptr Ks, const bf16x8 (&qr)[4], int r32, int hi) {
    lds_cptr kb = Ks + hi * 1024 + r32 * 16;
    p0 = f32x16{}; p1 = f32x16{};
#pragma unroll
    for (int d0 = 0; d0 < 4; ++d0) {
        const bf16x8 b0 = *(const MXA_LAS bf16x8*)(kb + d0 * 2048);
        const bf16x8 b1 = *(const MXA_LAS bf16x8*)(kb + d0 * 2048 + 512);
        p0 = __builtin_amdgcn_mfma_f32_32x32x16_bf16(b0, qr[d0], p0, 0, 0, 0);
        p1 = __builtin_amdgcn_mfma_f32_32x32x16_bf16(b1, qr[d0], p1, 0, 0, 0);
    }
}
__device__ __forceinline__ float sel_ninf(float x, int d) {
    const unsigned mk = (unsigned)(d >> 31);
    return __builtin_bit_cast(float, (__builtin_bit_cast(unsigned, x) & ~mk) | (0xff800000u & mk));
}
__device__ __forceinline__ void mask_le(f32x16& p0, f32x16& p1, int thr, int hi) {
    const int t0 = thr - 4 * hi;
#pragma unroll
    for (int r = 0; r < 16; ++r) { const int c = (r & 3) + 8 * (r >> 2); p0[r] = sel_ninf(p0[r], t0 - c); p1[r] = sel_ninf(p1[r], t0 - c - 32); }
}
__device__ __forceinline__ void mask_ge(f32x16& p0, f32x16& p1, int thr, int hi) {
    const int t0 = 4 * hi - thr;
#pragma unroll
    for (int r = 0; r < 16; ++r) { const int c = (r & 3) + 8 * (r >> 2); p0[r] = sel_ninf(p0[r], t0 + c); p1[r] = sel_ninf(p1[r], t0 + c + 32); }
}
__device__ __forceinline__ float rowmax32(const f32x16& p0, const f32x16& p1) {
    float a = fmaxf(p0[0], p1[0]);
#pragma unroll
    for (int r = 1; r < 16; ++r) a = fmaxf(a, fmaxf(p0[r], p1[r]));
    return fmaxf(a, __shfl_xor(a, 32));
}
__device__ __forceinline__ void softmax_pv(f32x16& p0, f32x16& p1, float& m, float& lsum, f32x16 (&o)[2], lds_cptr Vs, MXA_LAS float* wsf, int lane, int r32, int hi) {
    const float rm = rowmax32(p0, p1);
    const float mn = fmaxf(m, rm);
    const float ms = (mn == -INFINITY) ? 0.f : mn;
    const float alpha = ex2(m - ms);
    float rs = 0.f;
#pragma unroll
    for (int r = 0; r < 16; ++r) { p0[r] = ex2(p0[r] - ms); p1[r] = ex2(p1[r] - ms); rs += p0[r] + p1[r]; }
    lsum = lsum * alpha + rs; m = mn;
    if (__any(alpha != 1.f)) {
        if (hi == 0) wsf[r32] = alpha;
        asm volatile("s_waitcnt lgkmcnt(0)" ::: "memory");
#pragma unroll
        for (int r = 0; r < 16; ++r) { const float f = wsf[crow(r, hi)]; o[0][r] *= f; o[1][r] *= f; }
        asm volatile("s_waitcnt lgkmcnt(0)" ::: "memory");
    }
    u32x4 pw[4];
#pragma unroll
    for (int k = 0; k < 4; ++k) {
        pw[0][k] = cvtpk(p0[2 * k], p0[2 * k + 1]); pw[1][k] = cvtpk(p0[8 + 2 * k], p0[8 + 2 * k + 1]);
        pw[2][k] = cvtpk(p1[2 * k], p1[2 * k + 1]); pw[3][k] = cvtpk(p1[8 + 2 * k], p1[8 + 2 * k + 1]);
    }
    lds_cptr vp = Vs + ((lane >> 4) & 1) * 32 + (lane & 3) * 8 + (4 * hi + ((lane & 15) >> 2)) * 64;
#pragma unroll
    for (int dh = 0; dh < 2; ++dh)
#pragma unroll
        for (int ks = 0; ks < 4; ++ks) {
            const s16x4 lo = vtr(vp + dh * 4096 + ks * 1024), hh = vtr(vp + dh * 4096 + ks * 1024 + 512);
            const bf16x8 vf = {lo[0], lo[1], lo[2], lo[3], hh[0], hh[1], hh[2], hh[3]};
            o[dh] = __builtin_amdgcn_mfma_f32_32x32x16_bf16(__builtin_bit_cast(bf16x8, pw[ks]), vf, o[dh], 0, 0, 0);
        }
}

__device__ __forceinline__ void unit(const Args& a, unsigned char* lds_raw, int b, int g, int T) {
    const int tid = threadIdx.x, lane = tid & 63, w = __builtin_amdgcn_readfirstlane(tid >> 6), r32 = lane & 31, hi = lane >> 5;
    MXA_LAS char* L = (MXA_LAS char*)lds_raw;
    MXA_LAS float* wsf = (MXA_LAS float*)(L + L_WSF) + w * 64;
    MXA_LAS float* SC = (MXA_LAS float*)(L + L_SC);
    MXA_LAS unsigned* MK = (MXA_LAS unsigned*)(L + L_MASK);
    const bf16* P = (const bf16*)(a.ws + WS_PROJ);
    const bf16* Pb = P + (size_t)b * SEQ * NP;
    const int a_i = 8 * w + (r32 >> 2);
    const int head = g * 4 + (r32 & 3);
    const int t_i = 64 * T + a_i;
    bf16x8 qr[4];
    { const bf16* qrow = Pb + (size_t)t_i * NP + C_QA + head * 64;
#pragma unroll
      for (int d0 = 0; d0 < 4; ++d0) qr[d0] = *(const bf16x8*)(qrow + d0 * 16 + hi * 8); }
    const float* G = (const float*)(a.ws + WS_GATE) + (size_t)(b * SEQ + t_i) * 24;
    const int cmax_i = (t_i >= 31) ? ((t_i - 31) >> 4) : -1;
    const int cm_min = (T > 0) ? (4 * T - 2) : -1;
    const int ntc = ((4 * T + 2) >> 6) + 1;
    MXA_LAS float* TOT = (MXA_LAS float*)(L + L_TOT) + w * 2048 + lane;
    unsigned mk0 = 0, mk1 = 0, mk2 = 0, mk3 = 0;
    const int vkey = 16 * (w & 3) + (lane >> 2), vcol = (w >> 2) * 32 + (lane & 3) * 8;
    const unsigned sdst = (unsigned)(w * 1024 + lane * 16);
#pragma unroll 1
    for (int br = 0; br < 3; ++br) {
        const bf16* Kb; const bf16* Vb; size_t pitch; int tile0, nt;
        if (br == 0) { Kb = (const bf16*)(a.ws + WS_KC) + (size_t)(b * 2 + g) * 512 * 64; Vb = (const bf16*)(a.ws + WS_VC) + (size_t)(b * 2 + g) * 512 * 64; pitch = 64; tile0 = 0; nt = ntc; }
        else if (br == 1) { Kb = Pb + C_KSLC + g * 64; Vb = Pb + C_VSLC + g * 64; pitch = NP; tile0 = 0; nt = T + 1; }
        else { Kb = Pb + C_KWIN + g * 64; Vb = Pb + C_VWIN + g * 64; pitch = NP; tile0 = (T >= 8) ? T - 8 : 0; nt = T - tile0 + 1; }
        float m = -INFINITY, lsum = 0.f; f32x16 o[2]; o[0] = f32x16{}; o[1] = f32x16{};
        const bf16* ksrc = Kb + (size_t)lane * pitch + w * 8;
        const bf16* vsrc = Vb + (size_t)vkey * pitch + vcol;
        u32x4 kreg = *(const u32x4*)(ksrc + (size_t)tile0 * 64 * pitch), vreg = *(const u32x4*)(vsrc + (size_t)tile0 * 64 * pitch);
        *(MXA_LAS u32x4*)(L + sdst) = kreg; *(MXA_LAS u32x4*)(L + 8192 + sdst) = vreg;
        __syncthreads();
#pragma unroll 1
        for (int n = 0; n < nt; ++n) {
            const int k = tile0 + n;
            if (n + 1 < nt) { kreg = *(const u32x4*)(ksrc + (size_t)(k + 1) * 64 * pitch); vreg = *(const u32x4*)(vsrc + (size_t)(k + 1) * 64 * pitch); }
            lds_cptr Ks = (lds_cptr)(L + (n & 1) * SLOT), Vs = Ks + 8192;
            bool sel = true;
            if (br == 1) { const unsigned wsel = (k < 32) ? mk0 : (k < 64) ? mk1 : (k < 96) ? mk2 : mk3; sel = (wsel >> (k & 31)) & 1u; }
            if (__any(sel)) {
                f32x16 p0, p1; qkt(p0, p1, Ks, qr, r32, hi);
                if (br == 0) { if (64 * k + 63 > cm_min) mask_le(p0, p1, cmax_i - 64 * k, hi); }
                else if (br == 1) { if (k == T) mask_le(p0, p1, a_i, hi); if (!sel) mask_le(p0, p1, -1, hi); }
                else { if (k == T) mask_le(p0, p1, a_i, hi); if (k == T - 8) mask_ge(p0, p1, a_i + 1, hi); }
                softmax_pv(p0, p1, m, lsum, o, Vs, wsf, lane, r32, hi);
            }
            if (n + 1 < nt) { *(MXA_LAS u32x4*)(L + ((n + 1) & 1) * SLOT + sdst) = kreg; *(MXA_LAS u32x4*)(L + ((n + 1) & 1) * SLOT + 8192 + sdst) = vreg; }
            __syncthreads();
        }
        const float ltot = lsum + __shfl_xor(lsum, 32);
        const float rl = (ltot > 0.f) ? 1.f / ltot : 0.f;
        if (hi == 0) wsf[r32] = G[br * 8 + head] * rl;
        asm volatile("s_waitcnt lgkmcnt(0)" ::: "memory");
#pragma unroll
        for (int r = 0; r < 16; ++r) { const float f = wsf[crow(r, hi)];
            if (br == 0) { TOT[(2 * r) * 64] = o[0][r] * f; TOT[(2 * r + 1) * 64] = o[1][r] * f; }
            else { TOT[(2 * r) * 64] += o[0][r] * f; TOT[(2 * r + 1) * 64] += o[1][r] * f; } }
        asm volatile("s_waitcnt lgkmcnt(0)" ::: "memory");
        if (br == 0) {
            if (T >= 16) {
                kreg = *(const u32x4*)(ksrc);
                *(MXA_LAS u32x4*)(L + sdst) = kreg;
                __syncthreads();
                float carry = 0.f;
#pragma unroll 1
                for (int n = 0; n < nt; ++n) {
                    if (n + 1 < nt) kreg = *(const u32x4*)(ksrc + (size_t)(n + 1) * 64 * pitch);
                    lds_cptr Ks = (lds_cptr)(L + (n & 1) * SLOT);
                    f32x16 p0, p1; qkt(p0, p1, Ks, qr, r32, hi);
                    if (64 * n + 63 > cm_min) mask_le(p0, p1, cmax_i - 64 * n, hi);
                    const float ms = (m == -INFINITY) ? 0.f : m;
#pragma unroll
                    for (int r = 0; r < 16; ++r) {
                        float v0 = ex2(p0[r] - ms) * rl, v1 = ex2(p1[r] - ms) * rl;
                        v0 += __shfl_xor(v0, 1); v1 += __shfl_xor(v1, 1); v0 += __shfl_xor(v0, 2); v1 += __shfl_xor(v1, 2);
                        p0[r] = v0; p1[r] = v1;
                    }
#pragma unroll
                    for (int gi = 0; gi < 8; ++gi) {
                        const int hf = gi >> 2, q4 = gi & 3;
                        const float a0 = hf ? p1[4 * q4] : p0[4 * q4], a1 = hf ? p1[4 * q4 + 1] : p0[4 * q4 + 1], a2 = hf ? p1[4 * q4 + 2] : p0[4 * q4 + 2], a3 = hf ? p1[4 * q4 + 3] : p0[4 * q4 + 3];
                        const float y = __shfl_xor(a3, 32);
                        const float prev = hi ? y : carry;
                        carry = y;
                        const float sj = 2.f * (a0 + a1 + a2) + a3 + prev;
                        const int j = 16 * n + 8 * hf + 2 * q4 + hi;
                        if ((r32 & 3) == 0) SC[a_i * 128 + j] = sj;
                    }
                    if (n + 1 < nt) *(MXA_LAS u32x4*)(L + ((n + 1) & 1) * SLOT + sdst) = kreg;
                    __syncthreads();
                }
            }
            {
                const int tk = 8 * w + (lane >> 3), sub = lane & 7;
                unsigned mw[4] = {0u, 0u, 0u, 0u};
                if (T < 16) { mw[0] = (T >= 31) ? 0xffffffffu : ((2u << T) - 1u); }
                else {
                    float v[16];
#pragma unroll
                    for (int e = 0; e < 16; ++e) { const int j = sub + 8 * e; v[e] = (j >= 1 && j <= T - 2) ? SC[tk * 128 + j] : -1.f; }
#pragma unroll 1
                    for (int it = 0; it < 13; ++it) {
                        float bv = v[0]; int bi = sub;
#pragma unroll
                        for (int e = 1; e < 16; ++e) { if (v[e] > bv) { bv = v[e]; bi = sub + 8 * e; } }
#pragma unroll
                        for (int off = 1; off < 8; off <<= 1) {
                            const float ov = __shfl_xor(bv, off); const int oi = __shfl_xor(bi, off);
                            if (ov > bv || (ov == bv && oi < bi)) { bv = ov; bi = oi; }
                        }
#pragma unroll
                        for (int e = 0; e < 16; ++e) if (bi == sub + 8 * e) v[e] = -2.f;
#pragma unroll
                        for (int q = 0; q < 4; ++q) if ((bi >> 5) == q) mw[q] |= 1u << (bi & 31);
                    }
#pragma unroll
                    for (int q = 0; q < 4; ++q) { if (q == 0) mw[q] |= 1u; if (((T - 1) >> 5) == q) mw[q] |= 1u << ((T - 1) & 31); if ((T >> 5) == q) mw[q] |= 1u << (T & 31); }
                }
                if (sub == 0) {
#pragma unroll
                    for (int q = 0; q < 4; ++q) MK[tk * 4 + q] = mw[q];
                }
                asm volatile("s_waitcnt lgkmcnt(0)" ::: "memory");
                mk0 = MK[a_i * 4 + 0]; mk1 = MK[a_i * 4 + 1]; mk2 = MK[a_i * 4 + 2]; mk3 = MK[a_i * 4 + 3];
                asm volatile("s_waitcnt lgkmcnt(0)" ::: "memory");
            }
        }
    }
    bf16* MX = (bf16*)(a.ws + WS_H);
#pragma unroll
    for (int r = 0; r < 16; ++r) {
        const int q = crow(r, hi), tok = b * SEQ + 64 * T + 8 * w + (q >> 2), hd = g * 4 + (q & 3);
#pragma unroll
        for (int dh = 0; dh < 2; ++dh) {
            const int col = hd * 64 + dh * 32 + r32;
            const float z = bf2f(P[(size_t)tok * NP + C_ZA + col]);
            MX[(size_t)tok * DM + col] = (bf16)f2bf(TOT[(2 * r + dh) * 64] * z);
        }
    }
}
}


namespace mxb {
using namespace mxa;
__device__ __forceinline__ void dil_unit(const Args& a, unsigned char* lds_raw, int b, int h, int p, int res, int ch) {
    const int tid = threadIdx.x, lane = tid & 63, w = __builtin_amdgcn_readfirstlane(tid >> 6), r32 = lane & 31, hi = lane >> 5;
    MXA_LAS char* L = (MXA_LAS char*)lds_raw;
    MXA_LAS float* wsf = (MXA_LAS float*)(L + L_WSF) + w * 64;
    const int dil = (p == 0) ? 1 : (p == 1) ? 4 : 16;
    const bf16* P = (const bf16*)(a.ws + WS_PROJ);
    const bf16* Pr = P + (size_t)(b * SEQ + res) * NP;
    const size_t pitch = (size_t)dil * NP;
    const int i0 = ch * 256, ri = 32 * w + r32;
    bf16x8 qr[4];
    { const bf16* qrow = Pr + (size_t)(i0 + ri) * pitch + C_QB + h * 64;
#pragma unroll
      for (int d0 = 0; d0 < 4; ++d0) qr[d0] = *(const bf16x8*)(qrow + d0 * 16 + hi * 8); }
    const int kt0 = (i0 == 0) ? 2 : 0;
    const int lo = (128 - i0 > ri) ? 128 - i0 : ri;
    const int wk0 = w >> 1;
    const int vkey = 16 * (w & 3) + (lane >> 2), vcol = (w >> 2) * 32 + (lane & 3) * 8;
    const unsigned sdst = (unsigned)(w * 1024 + lane * 16);
    const bf16* ksrc = Pr + (ptrdiff_t)(i0 - 128 + lane) * (ptrdiff_t)pitch + C_KB + h * 64 + w * 8;
    const bf16* vsrc = Pr + (ptrdiff_t)(i0 - 128 + vkey) * (ptrdiff_t)pitch + C_VB + h * 64 + vcol;
    float m = -INFINITY, lsum = 0.f; f32x16 o[2]; o[0] = f32x16{}; o[1] = f32x16{};
    u32x4 kreg = *(const u32x4*)(ksrc + (size_t)kt0 * 64 * pitch), vreg = *(const u32x4*)(vsrc + (size_t)kt0 * 64 * pitch);
    *(MXA_LAS u32x4*)(L + sdst) = kreg; *(MXA_LAS u32x4*)(L + 8192 + sdst) = vreg;
    __syncthreads();
#pragma unroll 1
    for (int kt = kt0; kt < 6; ++kt) {
        const int n = kt - kt0;
        if (kt + 1 < 6) { kreg = *(const u32x4*)(ksrc + (size_t)(kt + 1) * 64 * pitch); vreg = *(const u32x4*)(vsrc + (size_t)(kt + 1) * 64 * pitch); }
        lds_cptr Ks = (lds_cptr)(L + (n & 1) * SLOT), Vs = Ks + 8192;
        if (kt >= wk0 && kt <= wk0 + 2) {
            f32x16 p0, p1; qkt(p0, p1, Ks, qr, r32, hi);
            mask_ge(p0, p1, lo - 64 * kt, hi);
            mask_le(p0, p1, ri + 128 - 64 * kt, hi);
            softmax_pv(p0, p1, m, lsum, o, Vs, wsf, lane, r32, hi);
        }
        if (kt + 1 < 6) { *(MXA_LAS u32x4*)(L + ((n + 1) & 1) * SLOT + sdst) = kreg; *(MXA_LAS u32x4*)(L + ((n + 1) & 1) * SLOT + 8192 + sdst) = vreg; }
        __syncthreads();
    }
    const float ltot = lsum + __shfl_xor(lsum, 32);
    const float rl = 1.f / ltot;
    const int tok_i = b * SEQ + (i0 + ri) * dil + res;
    if (hi == 0) { wsf[r32] = rl; ((float*)(a.ws + WS_LSEB))[((size_t)p * NTOK + tok_i) * 8 + h] = m + log2f(ltot); }
    asm volatile("s_waitcnt lgkmcnt(0)" ::: "memory");
    bf16* OB = (bf16*)(a.ws + WS_OB) + (size_t)p * NTOK * 512;
#pragma unroll
    for (int r = 0; r < 16; ++r) {
        const int q = crow(r, hi); const float f = wsf[q];
        const size_t tok = (size_t)b * SEQ + (size_t)(i0 + 32 * w + q) * dil + res;
        OB[tok * 512 + h * 64 + r32] = (bf16)f2bf(o[0][r] * f);
        OB[tok * 512 + h * 64 + 32 + r32] = (bf16)f2bf(o[1][r] * f);
    }
    asm volatile("s_waitcnt lgkmcnt(0)" ::: "memory");
}
__device__ __forceinline__ void cmp_unit(const Args& a, unsigned char* lds_raw, int prob, int cb) {
    const int tid = threadIdx.x, lane = tid & 63, w = __builtin_amdgcn_readfirstlane(tid >> 6), r32 = lane & 31, hi = lane >> 5;
    MXA_LAS char* L = (MXA_LAS char*)lds_raw;
    const int kv = prob & 1, bg = prob >> 1, b = bg >> 1, g = bg & 1, c0 = cb * 32;
    const bf16* src = (const bf16*)(a.ws + WS_PROJ) + (size_t)b * SEQ * NP + (kv ? C_VCMP : C_KCMP) + g * 64;
    const bf16* W1T = (const bf16*)(a.ws + WS_W1T) + (size_t)kv * 256 * 2048;
    const bf16* W2T = (const bf16*)(a.ws + WS_W2T) + (size_t)kv * 64 * 256;
    const float* bias = (const float*)(a.ws + WS_CMPB) + kv * 256;
    int tb = 16 * (c0 + r32); tb = (tb > SEQ - 32) ? SEQ - 32 : tb;
    const bf16* arow = src + (size_t)tb * NP + 8 * hi;
    const bf16* brow = W1T + (size_t)(32 * w + r32) * 2048 + 8 * hi;
    f32x16 acc = f32x16{};
#pragma unroll 1
    for (int s0 = 0; s0 < 128; s0 += 8) {
        bf16x8 af[8], bf_[8];
#pragma unroll
        for (int u = 0; u < 8; ++u) { const int s = s0 + u; af[u] = *(const bf16x8*)(arow + (size_t)(s >> 2) * NP + (s & 3) * 16); bf_[u] = *(const bf16x8*)(brow + s * 16); }
#pragma unroll
        for (int u = 0; u < 8; ++u) acc = __builtin_amdgcn_mfma_f32_32x32x16_bf16(af[u], bf_[u], acc, 0, 0, 0);
    }
    { const float bn = bias[32 * w + r32];
      MXA_LAS unsigned short* HID = (MXA_LAS unsigned short*)L;
#pragma unroll
      for (int r = 0; r < 16; ++r) { const float v = acc[r] + bn; HID[crow(r, hi) * 264 + 32 * w + r32] = (unsigned short)f2bf(v / (1.f + __expf(-v))); } }
    __syncthreads();
    if (w < 2) {
        f32x16 o2 = f32x16{};
        const bf16* b2 = W2T + (size_t)(32 * w + r32) * 256 + 8 * hi;
#pragma unroll
        for (int s = 0; s < 16; ++s) {
            const bf16x8 af = *(const MXA_LAS bf16x8*)(L + (r32 * 264 + s * 16 + 8 * hi) * 2);
            const bf16x8 bfr = *(const bf16x8*)(b2 + s * 16);
            o2 = __builtin_amdgcn_mfma_f32_32x32x16_bf16(af, bfr, o2, 0, 0, 0);
        }
        bf16* dst = (bf16*)(a.ws + (kv ? WS_VC : WS_KC)) + (size_t)bg * 512 * 64;
#pragma unroll
        for (int r = 0; r < 16; ++r) { const int c = c0 + crow(r, hi); dst[(size_t)c * 64 + 32 * w + r32] = (bf16)(c < 511 ? f2bf(o2[r]) : 0u); }
    }
    __syncthreads();
}
}

__device__ void p4_naive(const Args& a, float* lds) {
    const int tid = threadIdx.x, lane = tid & 63, wave = __builtin_amdgcn_readfirstlane(tid >> 6);
    float* Ms = lds;
    float* red = lds + 16 * 1024;
    const bf16* MX = (const bf16*)(a.ws + WS_H);
    for (int blk = blockIdx.x; blk < NTOK / 16; blk += gridDim.x) {
        const int row0 = blk * 16;
        for (int i = tid; i < 16 * 1024 / 2; i += NTHR) { const u32 w = ((const u32*)(MX + (size_t)row0 * DM))[i]; Ms[2 * i] = bflo(w); Ms[2 * i + 1] = bfhi(w); }
        __syncthreads();
        float acc[16][2];
#pragma unroll
        for (int r = 0; r < 16; ++r) { acc[r][0] = 0.f; acc[r][1] = 0.f; }
        for (int k = 0; k < DM; ++k) {
            const float2 w = *(const float2*)(a.w_out + (size_t)k * DM + 2 * tid);
#pragma unroll
            for (int r = 0; r < 16; ++r) { const float m = Ms[r * 1024 + k]; acc[r][0] += m * w.x; acc[r][1] += m * w.y; }
        }
#pragma unroll
        for (int r = 0; r < 16; ++r) { const float s = wave_sum(acc[r][0] * acc[r][0] + acc[r][1] * acc[r][1]); if (lane == 0) red[r * 8 + wave] = s; }
        __syncthreads();
        const float2 pg = *(const float2*)(a.post_g + 2 * tid);
#pragma unroll
        for (int r = 0; r < 16; ++r) {
            float s = 0.f;
#pragma unroll
            for (int q = 0; q < 8; ++q) s += red[r * 8 + q];
            const float rinv = rsqrtf(s * (1.f / DM) + RMS_EPS);
            const float2 xv = *(const float2*)(a.x + (size_t)(row0 + r) * DM + 2 * tid);
            float2 o; o.x = xv.x + acc[r][0] * rinv * pg.x; o.y = xv.y + acc[r][1] * rinv * pg.y;
            *(float2*)(a.out + (size_t)(row0 + r) * DM + 2 * tid) = o;
        }
        __syncthreads();
    }
}

constexpr int LDS_BYTES = 147456;
__global__ void __launch_bounds__(NTHR, 2) mk_fwd(Args a) {
    extern __shared__ __attribute__((aligned(16))) unsigned char lds_raw[];
    float* lds = (float*)lds_raw;
    cg::grid_group grid = cg::this_grid();
    const int tid = threadIdx.x, lane = tid & 63, wave = __builtin_amdgcn_readfirstlane(tid >> 6);
    const int gw = blockIdx.x * NWAVE + wave, ngw = gridDim.x * NWAVE;
#define IN(k) (a.ph_lo <= (k) && (k) < a.ph_hi)
#define SEAM(k) do { if (IN(k) && IN((k) + 1)) { __threadfence(); grid.sync(); } } while (0)
    if (IN(0)) p0_prologue(a, lds);
    SEAM(0);
    if (IN(1)) {
        pg8::Gemm g{(const pg8::bf16_t*)(a.ws + WS_H), (const pg8::bf16_t*)(a.ws + WS_WTIN), NTOK, NP, DM};
        pg8::StaticOrder S; S.init(NTOK, NP, (int)gridDim.x, (int)blockIdx.x);
        pg8::EpiProj E{(pg8::bf16_t*)(a.ws + WS_PROJ), (float*)(a.ws + WS_GATE), (const float*)(a.ws + WS_ROPE), C2};
        pg8::gemm_phase<pg8::EpiProj, pg8::StaticOrder, true, true>((PG8_LAS unsigned char*)lds_raw, g, S, E);
    }
    SEAM(1);
    if (IN(2)) {
        const int G_ = (int)gridDim.x, bx = (int)blockIdx.x, vcu = (G_ % 8 == 0) ? (bx % 8) * (G_ / 8) + bx / 8 : bx;
        for (int u = vcu; u < 128; u += G_) mxb::cmp_unit(a, lds_raw, u >> 4, u & 15);
        for (int u = vcu * 6; u < 1536; u += G_ * 6) {
            for (int q = 0; q < 6 && u + q < 1536; ++q) {
                const int uu = u + q, x = uu & 31, bhp = uu >> 5, p = bhp % 3, bh = bhp / 3;
                const int nch = (p == 0) ? 32 : (p == 1) ? 8 : 2;
                mxb::dil_unit(a, lds_raw, bh >> 3, bh & 7, p, x / nch, x % nch);
            }
        }
    }
    SEAM(2);
    if (IN(3)) {
        float* lw = lds + wave * 1024;
        for (int tok = gw; tok < NTOK; tok += ngw) p3_combine(a, tok, lane);
        __syncthreads();
        {
            const int G_ = (int)gridDim.x, bx = (int)blockIdx.x, vcu = (G_ % 8 == 0) ? (bx % 8) * (G_ / 8) + bx / 8 : bx;
            for (int u = vcu; u < 256; u += G_) {
                const int bg = u >> 6, s_ = u & 63;
                mxa::unit(a, lds_raw, bg >> 1, bg & 1, s_);
                mxa::unit(a, lds_raw, bg >> 1, bg & 1, 127 - s_);
            }
        }
    }
    SEAM(3);
    if (IN(4)) p4_naive(a, lds);
#undef IN
#undef SEAM
}

extern "C" void kernel_launch(void* const* d_in, const int* in_sizes, int n_in, void* d_out, int out_size, void* d_ws, size_t ws_size, hipStream_t stream) {
    static int grid_blocks = 0;
    if (!grid_blocks) {
        int dev = 0, cus = 0, per_cu = 0;
        (void)hipGetDevice(&dev);
        (void)hipDeviceGetAttribute(&cus, hipDeviceAttributeMultiprocessorCount, dev);
        (void)hipFuncSetAttribute((const void*)mk_fwd, hipFuncAttributeMaxDynamicSharedMemorySize, LDS_BYTES);
        (void)hipOccupancyMaxActiveBlocksPerMultiprocessor(&per_cu, mk_fwd, NTHR, LDS_BYTES);
        if (per_cu < 1) { fprintf(stderr, "kernel_launch: occupancy query says %d blocks per CU\n", per_cu); per_cu = 1; }
        grid_blocks = cus;
        if (ws_size < WS_END) fprintf(stderr, "kernel_launch: workspace too small (%zu)\n", ws_size);
    }
    Args a{};
    a.x = (const float*)d_in[0]; a.pos = (const int*)d_in[1]; a.pre_g = (const float*)d_in[2]; a.w_in = (const float*)d_in[3];
    a.ck_pos = (const float*)d_in[4]; a.ck_w1 = (const float*)d_in[5]; a.ck_w2 = (const float*)d_in[6];
    a.cv_pos = (const float*)d_in[7]; a.cv_w1 = (const float*)d_in[8]; a.cv_w2 = (const float*)d_in[9];
    a.w_out = (const float*)d_in[10]; a.post_g = (const float*)d_in[11];
    a.out = (float*)d_out; a.ws = (unsigned char*)d_ws; a.ph_lo = 0; a.ph_hi = 5;
    void* args[] = {&a};
    hipError_t e = hipLaunchCooperativeKernel((void*)mk_fwd, dim3(grid_blocks), dim3(NTHR), args, LDS_BYTES, stream);
    if (e != hipSuccess) fprintf(stderr, "cooperative launch failed: %s (grid %d)\n", hipGetErrorString(e), grid_blocks);
}
```
